# Optimizing an MI355X kernel written in HIP

```python
import math
import jax, jax.numpy as jnp
from jax import lax
import numpy as np

D_MODEL = 2048
BATCH = 8
SEQ = 2048
DEPTH = 1

N_META = 16
N_HEADS = 8
N_KV_HEADS = 2
HEAD_DIM = 128
ATTN_WIDTH = N_HEADS * HEAD_DIM
KV_WIDTH = N_KV_HEADS * HEAD_DIM
N_IDX_HEADS = 16
IDX_DIM = 64
TOPK_MAX = 256
CONV_WIDTH = D_MODEL // 2
CONV_K = 3
D_FF = 5632
ROPE_THETA = 500000.0
ROT_DIV = 4
Q_BLOCK = 128
EPS = 1e-6

kernel_name = "hybrid_dsa_shortconv_macaron_block"

SPLITS = [ATTN_WIDTH, KV_WIDTH, KV_WIDTH, N_IDX_HEADS * IDX_DIM, IDX_DIM, N_IDX_HEADS,
          CONV_WIDTH, CONV_WIDTH, CONV_WIDTH, D_MODEL, D_MODEL]
IN_COLS = int(sum(SPLITS))
SPLIT_POINTS = [int(v) for v in np.cumsum(SPLITS)[:-1]]


def rms_norm(x, g):
    xf = x.astype(jnp.float32)
    y = xf * lax.rsqrt(jnp.mean(xf * xf, axis=-1, keepdims=True) + EPS)
    return (y * g.astype(jnp.float32)).astype(x.dtype)


def swiglu(x, w_gate, w_up, w_down):
    return (jax.nn.silu(x @ w_gate) * (x @ w_up)) @ w_down


def rope_tables(n_pos, rot_dim):
    inv = ROPE_THETA ** (-jnp.arange(0, rot_dim, 2, dtype=jnp.float32) / rot_dim)
    ang = jnp.arange(n_pos, dtype=jnp.float32)[:, None] * inv[None, :]
    return jnp.cos(ang), jnp.sin(ang)


def partial_rope(x, cos, sin):
    half = cos.shape[-1]
    rot = 2 * half
    x1 = x[..., :half].astype(jnp.float32)
    x2 = x[..., half:rot].astype(jnp.float32)
    c = cos[None, :, None, :]
    s = sin[None, :, None, :]
    r1 = (x1 * c - x2 * s).astype(x.dtype)
    r2 = (x2 * c + x1 * s).astype(x.dtype)
    return jnp.concatenate([r1, r2, x[..., rot:]], axis=-1)


def causal_depthwise_conv(x, w, b):
    y = lax.conv_general_dilated(
        x, w[:, None, :].astype(x.dtype), window_strides=(1,),
        padding=[(CONV_K - 1, 0)], dimension_numbers=('NWC', 'WIO', 'NWC'),
        feature_group_count=x.shape[-1])
    return y + b.astype(x.dtype)


def dsa_sparse_attention(q, k, v, q_idx, k_idx, w_idx, k_sel):
    B, T = q.shape[0], q.shape[1]
    n_blk = -(-T // Q_BLOCK)
    Tp = n_blk * Q_BLOCK
    pad = Tp - T
    rep = N_HEADS // N_KV_HEADS

    def to_blocks(a):
        a = jnp.pad(a, [(0, 0), (0, pad)] + [(0, 0)] * (a.ndim - 2))
        return jnp.moveaxis(a.reshape((B, n_blk, Q_BLOCK) + a.shape[2:]), 1, 0)

    qpos = jnp.arange(Tp, dtype=jnp.int32).reshape(n_blk, Q_BLOCK)
    kpos = jnp.arange(T, dtype=jnp.int32)

    def block(args):
        qb, qib, wb, pb = args
        causal = kpos[None, :] <= pb[:, None]
        dots = jnp.einsum('bqhd,bsd->bqhs', qib, k_idx)
        isc = jnp.einsum('bqhs,bqh->bqs', jax.nn.relu(dots), wb).astype(jnp.float32)
        isc = jnp.where(causal[None], isc, -jnp.inf)
        _, sel = lax.top_k(isc, k_sel)
        valid = sel <= pb[None, :, None]
        ks = jax.vmap(lambda a, i: a[i])(k, sel)
        vs = jax.vmap(lambda a, i: a[i])(v, sel)
        qg = qb.reshape(B, Q_BLOCK, N_KV_HEADS, rep, HEAD_DIM)
        s = jnp.einsum('bqgrd,bqkgd->bqgrk', qg, ks).astype(jnp.float32) * (HEAD_DIM ** -0.5)
        s = jnp.where(valid[:, :, None, None, :], s, -jnp.inf)
        p = jax.nn.softmax(s, axis=-1).astype(vs.dtype)
        o = jnp.einsum('bqgrk,bqkgd->bqgrd', p, vs)
        return o.reshape(B, Q_BLOCK, ATTN_WIDTH)

    out = lax.map(block, (to_blocks(q), to_blocks(q_idx), to_blocks(w_idx), qpos))
    out = jnp.moveaxis(out, 0, 1).reshape(B, Tp, ATTN_WIDTH)[:, :T]
    return out


def setup_inputs(seed: int = 0) -> dict:
    key = jax.random.key(seed)
    ks = jax.random.split(key, 20)
    f32 = jnp.float32

    def w(k, shape, fan_in):
        return jax.random.normal(k, shape, f32) * (fan_in ** -0.5)

    def gain(k, shape):
        return 1.0 + 0.02 * jax.random.normal(k, shape, f32)

    L = DEPTH
    return {
        "x": jax.random.normal(ks[0], (BATCH, SEQ, D_MODEL), f32),
        "meta_tokens": jax.random.normal(ks[1], (N_META, D_MODEL), f32),
        "ffn1_norm_g": gain(ks[2], (L, D_MODEL)),
        "ffn1_w_gate": w(ks[3], (L, D_MODEL, D_FF), D_MODEL),
        "ffn1_w_up": w(ks[4], (L, D_MODEL, D_FF), D_MODEL),
        "ffn1_w_down": w(ks[5], (L, D_FF, D_MODEL), D_FF),
        "mix_norm_g": gain(ks[6], (L, D_MODEL)),
        "w_in": w(ks[7], (L, D_MODEL, IN_COLS), D_MODEL),
        "q_norm_g": gain(ks[8], (L, HEAD_DIM)),
        "k_norm_g": gain(ks[9], (L, HEAD_DIM)),
        "conv_w": w(ks[10], (L, CONV_K, CONV_WIDTH), CONV_K),
        "conv_b": 0.01 * jax.random.normal(ks[11], (L, CONV_WIDTH), f32),
        "w_attn_branch": w(ks[12], (L, ATTN_WIDTH, D_MODEL), ATTN_WIDTH),
        "w_conv_branch": w(ks[13], (L, CONV_WIDTH, D_MODEL), CONV_WIDTH),
        "w_out": w(ks[14], (L, D_MODEL, D_MODEL), D_MODEL),
        "ffn2_norm_g": gain(ks[15], (L, D_MODEL)),
        "ffn2_w_gate": w(ks[16], (L, D_MODEL, D_FF), D_MODEL),
        "ffn2_w_up": w(ks[17], (L, D_MODEL, D_FF), D_MODEL),
        "ffn2_w_down": w(ks[18], (L, D_FF, D_MODEL), D_FF),
    }


def reference(x, meta_tokens, ffn1_norm_g, ffn1_w_gate, ffn1_w_up, ffn1_w_down,
              mix_norm_g, w_in, q_norm_g, k_norm_g, conv_w, conv_b,
              w_attn_branch, w_conv_branch, w_out,
              ffn2_norm_g, ffn2_w_gate, ffn2_w_up, ffn2_w_down):
    B, S, D = x.shape
    meta = jnp.broadcast_to(meta_tokens[None].astype(x.dtype), (B, N_META, D))
    h = jnp.concatenate([meta, x], axis=1)
    T = h.shape[1]
    k_sel = min(TOPK_MAX, S // 4)
    cos_a, sin_a = rope_tables(T, HEAD_DIM // ROT_DIV)
    cos_i, sin_i = rope_tables(T, IDX_DIM // ROT_DIV)

    for l in range(DEPTH):
        u = rms_norm(h, ffn1_norm_g[l])
        h = h + 0.5 * swiglu(u, ffn1_w_gate[l], ffn1_w_up[l], ffn1_w_down[l])

        u = rms_norm(h, mix_norm_g[l])
        z = u @ w_in[l]
        q, k, v, qi, ki, wi, xc, gate_b, gate_c, ga, gc = jnp.split(z, SPLIT_POINTS, axis=-1)

        q = partial_rope(rms_norm(q.reshape(B, T, N_HEADS, HEAD_DIM), q_norm_g[l]), cos_a, sin_a)
        k = partial_rope(rms_norm(k.reshape(B, T, N_KV_HEADS, HEAD_DIM), k_norm_g[l]), cos_a, sin_a)
        v = v.reshape(B, T, N_KV_HEADS, HEAD_DIM)
        qi = partial_rope(qi.reshape(B, T, N_IDX_HEADS, IDX_DIM), cos_i, sin_i)
        ki = partial_rope(ki.reshape(B, T, 1, IDX_DIM), cos_i, sin_i)[:, :, 0]
        y_attn = dsa_sparse_attention(q, k, v, qi, ki, wi, k_sel) @ w_attn_branch[l]

        y_conv = (gate_b * causal_depthwise_conv(gate_c * xc, conv_w[l], conv_b[l])) @ w_conv_branch[l]

        merged = jax.nn.sigmoid(ga) * y_attn + jax.nn.sigmoid(gc) * y_conv
        h = h + merged @ w_out[l]

        u = rms_norm(h, ffn2_norm_g[l])
        h = h + 0.5 * swiglu(u, ffn2_w_gate[l], ffn2_w_up[l], ffn2_w_down[l])

    return h[:, N_META:]
```

```cpp
#include <hip/hip_runtime.h>
#include <hip/hip_cooperative_groups.h>
#include <cstdio>
namespace cg = cooperative_groups;

typedef unsigned short bf16_t;
typedef short bf16x8 __attribute__((ext_vector_type(8)));
typedef float f32x4 __attribute__((ext_vector_type(4)));
typedef float f32x16 __attribute__((ext_vector_type(16)));
typedef unsigned u32x4 __attribute__((ext_vector_type(4)));
typedef unsigned u32x2 __attribute__((ext_vector_type(2)));

constexpr int DM = 2048, NBATCH = 8, SEQ = 2048, NMETA = 16, TT = 2064, DFF = 5632;
constexpr int MMAIN = 16384, MPAD = 16640;
constexpr int LDZ = 2816, LDX = 1024, LDG = 4096;
constexpr int NIN = 9984;
constexpr int TPAD = 2080;
constexpr float EPS = 1e-6f;
constexpr int LDS_BYTES = 147472;

constexpr size_t WS_WGU = 0;
constexpr size_t WS_WD = WS_WGU + (size_t)11264 * 2048 * 2;
constexpr size_t WS_XCC = WS_WGU;
constexpr size_t WS_BB = WS_XCC + (size_t)MPAD * LDX * 2;
constexpr size_t WS_WGU2 = WS_WD + (size_t)2048 * 5632 * 2;
constexpr size_t WS_WD2 = WS_WGU2 + (size_t)11264 * 2048 * 2;
constexpr size_t WS_WIN = WS_WD2 + (size_t)2048 * 5632 * 2;
constexpr size_t WS_WA = WS_WIN + (size_t)NIN * 2048 * 2;
constexpr size_t WS_WC = WS_WA + (size_t)2048 * 1024 * 2;
constexpr size_t WS_WO = WS_WC + (size_t)2048 * 1024 * 2;
constexpr size_t WS_HB = WS_WO + (size_t)2048 * 2048 * 2;
constexpr size_t WS_Z1 = WS_HB + (size_t)MPAD * 2048 * 2;
constexpr size_t WS_G = WS_Z1 + (size_t)MPAD * LDZ * 2;
constexpr size_t WS_VT = WS_G + (size_t)MPAD * LDG * 2;
constexpr size_t WS_PART = WS_VT + (size_t)NBATCH * 2 * 128 * TPAD * 2;
constexpr size_t PART_SZ = (size_t)MPAD * 32 * 4;
constexpr size_t WS_HMETA = WS_PART + 3 * PART_SZ;
constexpr size_t WS_ROPE = WS_HMETA + (size_t)256 * 2048 * 4;
constexpr size_t WS_PARTM = WS_ROPE + (size_t)TT * 48 * 4;
constexpr size_t WS_BAR = WS_PARTM + 16 * 128 * 4;
constexpr size_t WS_KI2 = WS_BAR + 16384;
constexpr size_t WS_END = WS_KI2 + (size_t)NBATCH * 65 * 4096;
static_assert(WS_Z1 + (size_t)MPAD * DFF * 2 <= WS_VT, "act alias");
static_assert(WS_BB + (size_t)MPAD * LDX * 2 <= WS_WGU2, "xcc/bb alias");
static_assert(WS_END <= (size_t)536870912, "workspace");

__device__ __forceinline__ unsigned cvt_pk_bf16(float lo, float hi) { unsigned r; asm volatile("v_cvt_pk_bf16_f32 %0, %1, %2" : "=v"(r) : "v"(lo), "v"(hi)); return r; }
__device__ __forceinline__ float bf_lo(unsigned w) { return __uint_as_float(w << 16); }
__device__ __forceinline__ float bf_hi(unsigned w) { return __uint_as_float(w & 0xffff0000u); }
__device__ __forceinline__ float bf2f(bf16_t b) { return __uint_as_float(((unsigned)b) << 16); }
__device__ __forceinline__ float sigmoidf_(float x) { return __builtin_amdgcn_rcpf(1.0f + __expf(-x)); }
__device__ __forceinline__ void unpack8(const u32x4 w, float (&f)[8]) {
    f[0] = bf_lo(w.x); f[1] = bf_hi(w.x); f[2] = bf_lo(w.y); f[3] = bf_hi(w.y); f[4] = bf_lo(w.z); f[5] = bf_hi(w.z); f[6] = bf_lo(w.w); f[7] = bf_hi(w.w); }
__device__ __forceinline__ u32x4 pack8(const float (&f)[8]) { u32x4 w; w.x = cvt_pk_bf16(f[0], f[1]); w.y = cvt_pk_bf16(f[2], f[3]); w.z = cvt_pk_bf16(f[4], f[5]); w.w = cvt_pk_bf16(f[6], f[7]); return w; }
__device__ __forceinline__ void rstd8(const float* part, int row0, int fq, float (&rs)[8]) {
    f32x4 v[8][2];
#pragma unroll
    for (int k = 0; k < 8; ++k) { const f32x4* p = (const f32x4*)(part + (size_t)(row0 + (k >> 2) * 128 + (k & 3) * 16) * 32 + fq * 8); v[k][0] = p[0]; v[k][1] = p[1]; }
#pragma unroll
    for (int k = 0; k < 8; ++k) { float s = ((v[k][0][0] + v[k][0][1]) + (v[k][0][2] + v[k][0][3])) + ((v[k][1][0] + v[k][1][1]) + (v[k][1][2] + v[k][1][3]));
        s += __shfl_xor(s, 16); s += __shfl_xor(s, 32); rs[k] = rsqrtf(s * (1.0f / 2048.0f) + EPS); }
}

namespace pg8 {
#define PG8_LAS __attribute__((address_space(3)))
constexpr int BM = 256, BK = 64, HALF = 128, HTB = HALF * BK * 2, STAGE_BYTES = 8 * HTB, NXCD = 8, WGM = 8;
__host__ __device__ __forceinline__ int lds_byte(int r, int c) { const int st = (r >> 4) * 2 + (c >> 5), rr = r & 15, cc = c & 31, ob = rr * 64 + cc * 2; return st * 1024 + (ob ^ (((ob >> 9) & 1) << 5)); }
__host__ __device__ __forceinline__ void stage_rc(int b, int& R, int& C) { const int st = b / 1024, sb = b % 1024, swz = sb ^ (((sb >> 9) & 1) << 5); R = (st >> 1) * 16 + swz / 64; C = (st & 1) * 32 + (swz % 64) / 2; }
__host__ __device__ __forceinline__ int perm32(int rho) { const int n = rho >> 4, i = rho & 15; return 8 * (i >> 2) + 4 * n + (i & 3); }
struct Unit { int pm, pn; };
struct Gemm { const bf16_t* A; const bf16_t* Bt; int M, N, K, lda, ldb; };
struct StaticOrder {
    int nM, nN, nwg, G, c;
    __device__ void init(int M, int N, int G_, int c_) { nM = M / BM; nN = N / BM; nwg = nM * nN; G = G_; c = c_; }
    __device__ bool next(int i, Unit& u) const {
        const long L = (long)i * G + c; if (L >= nwg) return false;
        int wgid = (int)L; { const int q = nwg / NXCD, r = nwg % NXCD, xcd = wgid % NXCD, off = wgid / NXCD; wgid = (xcd < r ? xcd * (q + 1) : r * (q + 1) + (xcd - r) * q) + off; }
        const int nig = WGM * nN, gid = wgid / nig, fm = gid * WGM, gsz = (nM - fm) < WGM ? (nM - fm) : WGM;
        u.pm = fm + ((wgid % nig) % gsz); u.pn = (wgid % nig) / gsz; return true;
    }
};

template <class Epi>
__device__ __forceinline__ void gemm_phase(PG8_LAS unsigned char* lds, const Gemm g, const StaticOrder& S, const Epi& E) {
    const int tid = threadIdx.x, wid = __builtin_amdgcn_readfirstlane(tid >> 6), lane = tid & 63, wr = wid >> 2, wc = wid & 3, fr = lane & 15, fq = lane >> 4;
    const int K = g.K, nt = K / BK;
    unsigned voffA[2], voffB[2];
#pragma unroll
    for (int i = 0; i < 2; ++i) { int R, C; stage_rc(tid * 16 + i * 8192, R, C); const int Rb = Epi::PERM ? ((R & ~31) + perm32(R & 31)) : R;
        voffA[i] = (unsigned)(R * g.lda + C) * 2u; voffB[i] = (unsigned)(Rb * g.ldb + C) * 2u; }
    const size_t kstep = (size_t)(BK * 2);
    const size_t hstepA = (size_t)HALF * g.lda * 2, hstepB = (size_t)HALF * g.ldb * 2;
    const size_t tstepA = 2 * hstepA, tstepB = 2 * hstepB;
    const unsigned ldsw = (unsigned)wid * 1024u;
    const int aoff = lds_byte(wr * 64 + fr, fq * 8), boff = lds_byte(wc * 32 + fr, fq * 8);
#define PG8_SA(b, h) (((b) * 2 + (h)) * HTB)
#define PG8_SB(b, h) ((4 + (b) * 2 + (h)) * HTB)
#define PG8_STAGE(bufoff, gbase, voff) do { _Pragma("unroll") for (int _i = 0; _i < 2; ++_i) \
        __builtin_amdgcn_global_load_lds((const unsigned*)((const char*)(gbase) + (voff)[_i]), (PG8_LAS unsigned*)(lds + (bufoff) + ldsw + _i * 8192), 16, 0, 0); } while (0)
#define PG8_LDA(dst, b, h) do { _Pragma("unroll") for (int m = 0; m < 4; ++m) _Pragma("unroll") for (int k = 0; k < 2; ++k) dst[m][k] = *(const PG8_LAS bf16x8*)(lds + PG8_SA(b, h) + aoff + m * 2048 + k * 1024); } while (0)
#define PG8_LDB(dst, b, h) do { _Pragma("unroll") for (int n = 0; n < 2; ++n) _Pragma("unroll") for (int k = 0; k < 2; ++k) dst[n][k] = *(const PG8_LAS bf16x8*)(lds + PG8_SB(b, h) + boff + n * 2048 + k * 1024); } while (0)
#define PG8_MMA(ai, bj, At, Bt) do { __builtin_amdgcn_s_setprio(1); _Pragma("unroll") for (int m = 0; m < 4; ++m) _Pragma("unroll") for (int n = 0; n < 2; ++n) _Pragma("unroll") for (int k = 0; k < 2; ++k) \
        acc[ai][bj][m][n] = __builtin_amdgcn_mfma_f32_16x16x32_bf16(Bt[n][k], At[m][k], acc[ai][bj][m][n], 0, 0, 0); __builtin_amdgcn_s_setprio(0); } while (0)
#define PG8_WAIT_V(n) asm volatile("s_waitcnt vmcnt(" #n ")" ::: "memory")
#define PG8_WAIT_L(n) asm volatile("s_waitcnt lgkmcnt(" #n ")" ::: "memory")
#define PG8_BAR __builtin_amdgcn_s_barrier()
#define PG8_SCHED __builtin_amdgcn_sched_barrier(0)
    Unit cur, nxt; int ui = 0;
    if (!S.next(0, cur)) return;
    f32x4 acc[2][2][4][2];
#pragma unroll
    for (int a = 0; a < 2; ++a)
#pragma unroll
        for (int b = 0; b < 2; ++b)
#pragma unroll
            for (int m = 0; m < 4; ++m)
#pragma unroll
                for (int n = 0; n < 2; ++n) acc[a][b][m][n] = (f32x4){0.f, 0.f, 0.f, 0.f};
    bf16x8 At[4][2], B0[2][2], B1[2][2];
    const char* cA = (const char*)g.A + (size_t)cur.pm * tstepA; const char* cB = (const char*)g.Bt + (size_t)cur.pn * tstepB;
    PG8_STAGE(PG8_SB(0, 0), cB, voffB); PG8_STAGE(PG8_SA(0, 0), cA, voffA); PG8_STAGE(PG8_SB(0, 1), cB + hstepB, voffB); PG8_STAGE(PG8_SA(0, 1), cA + hstepA, voffA);
    if (wr == 1) PG8_BAR;
    PG8_WAIT_V(4); PG8_BAR;
    PG8_STAGE(PG8_SB(1, 0), cB + kstep, voffB); PG8_STAGE(PG8_SA(1, 0), cA + kstep, voffA); PG8_STAGE(PG8_SB(1, 1), cB + hstepB + kstep, voffB);
    PG8_WAIT_V(6); PG8_BAR;
    for (;;) {
        const bool has_next = S.next(ui + 1, nxt);
        const char* nA = has_next ? (const char*)g.A + (size_t)nxt.pm * tstepA : cA; const char* nB = has_next ? (const char*)g.Bt + (size_t)nxt.pn * tstepB : cB;
        for (int t = 0; t < nt; t += 2) {
            const bool last = (t == nt - 2);
            const char* a1 = cA + (size_t)(t + 1) * kstep;
            const char* a2 = last ? nA : cA + (size_t)(t + 2) * kstep; const char* b2 = last ? nB : cB + (size_t)(t + 2) * kstep;
            const char* a3 = a2 + kstep; const char* b3 = b2 + kstep;
            PG8_LDB(B0, 0, 0); PG8_SCHED; PG8_LDA(At, 0, 0); PG8_STAGE(PG8_SA(1, 1), a1 + hstepA, voffA);
            PG8_WAIT_L(8); PG8_BAR; PG8_WAIT_L(0); PG8_MMA(0, 0, At, B0); PG8_BAR; PG8_SCHED;
            PG8_LDB(B1, 0, 1); PG8_STAGE(PG8_SB(0, 0), b2, voffB);
            PG8_BAR; PG8_WAIT_L(0); PG8_MMA(0, 1, At, B1); PG8_BAR;
            PG8_LDA(At, 0, 1); PG8_STAGE(PG8_SA(0, 0), a2, voffA);
            PG8_BAR; PG8_WAIT_L(0); PG8_MMA(1, 0, At, B0); PG8_BAR; PG8_SCHED;
            PG8_STAGE(PG8_SB(0, 1), b2 + hstepB, voffB);
            PG8_WAIT_V(6); PG8_BAR; PG8_MMA(1, 1, At, B1); PG8_BAR;
            PG8_LDB(B0, 1, 0); PG8_SCHED; PG8_LDA(At, 1, 0); PG8_STAGE(PG8_SA(0, 1), a2 + hstepA, voffA);
            PG8_WAIT_L(8); PG8_BAR; PG8_WAIT_L(0); PG8_MMA(0, 0, At, B0); PG8_BAR; PG8_SCHED;
            PG8_LDB(B1, 1, 1); PG8_STAGE(PG8_SB(1, 0), b3, voffB);
            PG8_BAR; PG8_WAIT_L(0); PG8_MMA(0, 1, At, B1); PG8_BAR;
            PG8_LDA(At, 1, 1); PG8_STAGE(PG8_SA(1, 0), a3, voffA);
            PG8_BAR; PG8_WAIT_L(0); PG8_MMA(1, 0, At, B0); PG8_BAR; PG8_SCHED;
            PG8_STAGE(PG8_SB(1, 1), b3 + hstepB, voffB);
            PG8_WAIT_V(6); PG8_BAR; PG8_MMA(1, 1, At, B1); PG8_BAR;
        }
        E(acc, cur, wr, wc, fr, fq);
        if (!has_next) break;
#pragma unroll
        for (int a = 0; a < 2; ++a)
#pragma unroll
            for (int b = 0; b < 2; ++b)
#pragma unroll
                for (int m = 0; m < 4; ++m)
#pragma unroll
                    for (int n = 0; n < 2; ++n) acc[a][b][m][n] = (f32x4){0.f, 0.f, 0.f, 0.f};
        cur = nxt; cA = nA; cB = nB; ++ui;
    }
    PG8_WAIT_V(0);
    if (wr == 0) PG8_BAR;
    PG8_BAR;
#undef PG8_SA
#undef PG8_SB
#undef PG8_STAGE
#undef PG8_LDA
#undef PG8_LDB
#undef PG8_MMA
#undef PG8_WAIT_V
#undef PG8_WAIT_L
#undef PG8_BAR
#undef PG8_SCHED
}
}

struct EpiGU {
    static constexpr bool PERM = true;
    bf16_t* act; const float* part; PG8_LAS float* rs_lds; mutable int cached_pm;
    __device__ __forceinline__ void operator()(const f32x4 (&acc)[2][2][4][2], const pg8::Unit& u, int wr, int wc, int fr, int fq) const {
        const int row0 = u.pm * 256 + wr * 64 + fr, col0 = u.pn * 128 + wc * 32 + 8 * fq;
        float rsv[8]; PG8_LAS float* mine = rs_lds + (wr * 4 + wc) * 512 + fq * 16 + fr;
        if (u.pm != cached_pm) { rstd8(part, row0, fq, rsv);
#pragma unroll
            for (int k = 0; k < 8; ++k) mine[k * 64] = rsv[k];
            cached_pm = u.pm; }
        else {
#pragma unroll
            for (int k = 0; k < 8; ++k) rsv[k] = mine[k * 64]; }
#pragma unroll
        for (int ai = 0; ai < 2; ++ai)
#pragma unroll
            for (int m = 0; m < 4; ++m) {
                const int r = row0 + ai * 128 + m * 16; const float rs = rsv[ai * 4 + m];
                float o[8];
#pragma unroll
                for (int n = 0; n < 2; ++n)
#pragma unroll
                    for (int i = 0; i < 4; ++i) { const float gv = acc[ai][0][m][n][i] * rs, uv = acc[ai][1][m][n][i] * rs; o[n * 4 + i] = gv * sigmoidf_(gv) * uv; }
                *(u32x4*)(act + (size_t)r * DFF + col0) = pack8(o);
            }
    }
};
struct EpiRes {
    static constexpr bool PERM = true;
    const bf16_t* resb; float* outf; bf16_t* hb; float* part; float coef;
    __device__ __forceinline__ void operator()(const f32x4 (&acc)[2][2][4][2], const pg8::Unit& u, int wr, int wc, int fr, int fq) const {
        const int row0 = u.pm * 256 + wr * 64 + fr, col0 = u.pn * 256 + wc * 32 + 8 * fq;
#pragma unroll
        for (int ai = 0; ai < 2; ++ai) {
            u32x4 rb[4][2];
#pragma unroll
            for (int m = 0; m < 4; ++m)
#pragma unroll
                for (int bj = 0; bj < 2; ++bj) rb[m][bj] = *(const u32x4*)(resb + (size_t)(row0 + ai * 128 + m * 16) * DM + col0 + bj * 128);
#pragma unroll
            for (int m = 0; m < 4; ++m) {
                const int r = row0 + ai * 128 + m * 16; float ss = 0.f;
#pragma unroll
                for (int bj = 0; bj < 2; ++bj) {
                    const size_t off = (size_t)r * DM + col0 + bj * 128;
                    float rv[8], o[8]; unpack8(rb[m][bj], rv);
#pragma unroll
                    for (int n = 0; n < 2; ++n)
#pragma unroll
                        for (int i = 0; i < 4; ++i) o[n * 4 + i] = rv[n * 4 + i] + coef * acc[ai][bj][m][n][i];
                    if (outf) { *(f32x4*)(outf + off) = (f32x4){o[0], o[1], o[2], o[3]}; *(f32x4*)(outf + off + 4) = (f32x4){o[4], o[5], o[6], o[7]}; }
                    if (hb) { *(u32x4*)(hb + off) = pack8(o);
#pragma unroll
                        for (int i = 0; i < 8; ++i) ss += o[i] * o[i]; }
                }
                if (hb) { ss += __shfl_xor(ss, 16); ss += __shfl_xor(ss, 32); if (fq == 0) part[(size_t)r * 32 + u.pn * 4 + wc] = ss; }
            }
        }
    }
};
struct EpiZ {
    static constexpr bool PERM = true;
    bf16_t* Z1; bf16_t* XCC; bf16_t* BB; bf16_t* G; const float* part; const float* partm; PG8_LAS float* rs_lds; mutable int cached_pm;
    __device__ __forceinline__ void operator()(const f32x4 (&acc)[2][2][4][2], const pg8::Unit& u, int wr, int wc, int fr, int fq) const {
        const int row0 = u.pm * 256 + wr * 64 + fr; const int pn = u.pn;
        bf16_t* base; int ld, cb; const bool paired = (pn >= 11 && pn < 19);
        if (pn < 11) { base = Z1; ld = LDZ; cb = pn * 256; } else if (pn < 19) { base = XCC; ld = LDX; cb = (pn - 11) * 128; } else if (pn < 23) { base = BB; ld = LDX; cb = (pn - 19) * 256; } else { base = G; ld = LDG; cb = (pn - 23) * 256; }
        cb += wc * 32 + 8 * fq;
        float rsv[8]; PG8_LAS float* mine = rs_lds + (wr * 4 + wc) * 512 + fq * 16 + fr;
        if (u.pm < 64 && u.pm == cached_pm) {
#pragma unroll
            for (int k = 0; k < 8; ++k) rsv[k] = mine[k * 64]; }
        else if (u.pm < 64) { rstd8(part, row0, fq, rsv);
#pragma unroll
            for (int k = 0; k < 8; ++k) mine[k * 64] = rsv[k];
            cached_pm = u.pm; }
        else {
#pragma unroll
            for (int k = 0; k < 8; ++k) rsv[k] = 0.f;
            const f32x4* pp = (const f32x4*)(partm + fr * 128 + fq * 32); float sm = 0.f;
#pragma unroll
            for (int i = 0; i < 8; ++i) { const f32x4 v = pp[i]; sm += (v[0] + v[1]) + (v[2] + v[3]); }
            sm += __shfl_xor(sm, 16); sm += __shfl_xor(sm, 32);
            if (wr == 0) rsv[0] = rsqrtf(sm * (1.0f / 2048.0f) + EPS);
        }
#pragma unroll
        for (int ai = 0; ai < 2; ++ai)
#pragma unroll
            for (int m = 0; m < 4; ++m) {
                const int r = row0 + ai * 128 + m * 16; const float rs = rsv[ai * 4 + m];
                bf16_t* rowp = base + (size_t)r * ld + cb;
                if (paired) {
                    float o[8]; const float rs2 = rs * rs;
#pragma unroll
                    for (int n = 0; n < 2; ++n)
#pragma unroll
                        for (int i = 0; i < 4; ++i) o[n * 4 + i] = acc[ai][0][m][n][i] * acc[ai][1][m][n][i] * rs2;
                    *(u32x4*)rowp = pack8(o);
                } else {
#pragma unroll
                    for (int bj = 0; bj < 2; ++bj) { float o[8];
#pragma unroll
                        for (int n = 0; n < 2; ++n)
#pragma unroll
                            for (int i = 0; i < 4; ++i) o[n * 4 + i] = acc[ai][bj][m][n][i] * rs;
                        *(u32x4*)(rowp + bj * 128) = pack8(o); }
                }
            }
    }
};
struct EpiGate {
    static constexpr bool PERM = true;
    bf16_t* G; int mode;
    __device__ __forceinline__ void operator()(const f32x4 (&acc)[2][2][4][2], const pg8::Unit& u, int wr, int wc, int fr, int fq) const {
        const int row0 = u.pm * 256 + wr * 64 + fr, col0 = u.pn * 256 + wc * 32 + 8 * fq;
#pragma unroll
        for (int ai = 0; ai < 2; ++ai) {
            u32x4 la[4][2], lg[4][2];
#pragma unroll
            for (int m = 0; m < 4; ++m)
#pragma unroll
                for (int bj = 0; bj < 2; ++bj) { const bf16_t* p = G + (size_t)(row0 + ai * 128 + m * 16) * LDG + col0 + bj * 128;
                    la[m][bj] = *(const u32x4*)p; if (mode != 0) lg[m][bj] = *(const u32x4*)(p + 2048); else lg[m][bj] = la[m][bj]; }
#pragma unroll
            for (int m = 0; m < 4; ++m)
#pragma unroll
                for (int bj = 0; bj < 2; ++bj) {
                    bf16_t* p = G + (size_t)(row0 + ai * 128 + m * 16) * LDG + col0 + bj * 128;
                    float a[8], gt[8], o[8];
                    unpack8(la[m][bj], a);
                    if (mode == 0) {
#pragma unroll
                        for (int n = 0; n < 2; ++n)
#pragma unroll
                            for (int i = 0; i < 4; ++i) o[n * 4 + i] = sigmoidf_(a[n * 4 + i]) * acc[ai][bj][m][n][i];
                    } else {
                        unpack8(lg[m][bj], gt);
#pragma unroll
                        for (int n = 0; n < 2; ++n)
#pragma unroll
                            for (int i = 0; i < 4; ++i) o[n * 4 + i] = a[n * 4 + i] + sigmoidf_(gt[n * 4 + i]) * acc[ai][bj][m][n][i];
                    }
                    *(u32x4*)p = pack8(o);
                }
        }
    }
};

template <bool PAIR, int STEPS, class F>
__device__ __forceinline__ void skinny16(const bf16_t* A, int lda, const bf16_t* Bt, int K, int ntasks, unsigned char* lds, F&& epi) {
    const int lane = threadIdx.x & 63, wv_ = threadIdx.x >> 6, r = lane & 15, kq = lane >> 4;
    f32x4* red = (f32x4*)lds;
    for (int task = blockIdx.x; task < ntasks; task += gridDim.x) {
        int n0, n1;
        if (PAIR) { n0 = (task >> 3) * 256 + (task & 7) * 16; n1 = n0 + 128; } else { n0 = task * 16; n1 = n0; }
        const int kbeg = wv_ * STEPS * 32;
        const bf16_t* ap = A + (size_t)r * lda + kbeg + kq * 8;
        const bf16_t* b0 = Bt + (size_t)(n0 + r) * K + kbeg + kq * 8;
        const bf16_t* b1 = Bt + (size_t)(n1 + r) * K + kbeg + kq * 8;
        f32x4 acc0 = {0.f, 0.f, 0.f, 0.f}, acc1 = {0.f, 0.f, 0.f, 0.f};
#pragma unroll
        for (int st = 0; st < STEPS; ++st) {
            const bf16x8 a = *(const bf16x8*)(ap + st * 32), x0 = *(const bf16x8*)(b0 + st * 32);
            acc0 = __builtin_amdgcn_mfma_f32_16x16x32_bf16(a, x0, acc0, 0, 0, 0);
            if (PAIR) { const bf16x8 x1 = *(const bf16x8*)(b1 + st * 32); acc1 = __builtin_amdgcn_mfma_f32_16x16x32_bf16(a, x1, acc1, 0, 0, 0); }
        }
        red[(wv_ * 2 + 0) * 64 + lane] = acc0; if (PAIR) red[(wv_ * 2 + 1) * 64 + lane] = acc1;
        __syncthreads();
        if (wv_ == 0) {
            f32x4 s0 = red[lane], s1 = {0.f, 0.f, 0.f, 0.f}; if (PAIR) s1 = red[64 + lane];
#pragma unroll
            for (int w = 1; w < 8; ++w) { s0 += red[(w * 2) * 64 + lane]; if (PAIR) s1 += red[(w * 2 + 1) * 64 + lane]; }
            epi(s0, s1, task, n0, r, kq);
        }
        __syncthreads();
    }
}

struct ConvJob { const float* W0; const float* W1; const float* g; bf16_t* dst; int ldw, K, N, mode; };
__device__ __forceinline__ void convert_unit(const ConvJob& J, int u, int lane) {
    const int nkb = J.K / 32;
    {
        const int ch = u / nkb, kb = u % nkb;
        const int n = ch * 256 + lane * 4; const float* src = J.W0; int col = n;
        if (J.mode == 1) { col = (n >> 8) * 128 + (n & 127); if ((n >> 7) & 1) src = J.W1; }
        else if (J.mode == 2) { const int pn = n >> 8;
            if (pn < 11) col = (n < 2640) ? n : -1;
            else if (pn < 19) col = (((n >> 7) & 1) ? 4688 : 2640) + (pn - 11) * 128 + (n & 127);
            else if (pn < 23) col = 3664 + (n - 19 * 256);
            else col = 5712 + (n - 23 * 256); }
        const float* sp = src + (size_t)(kb * 32) * J.ldw + (col >= 0 ? col : 0);
        f32x4 v[4][8];
#pragma unroll
        for (int it = 0; it < 4; ++it)
#pragma unroll
            for (int i = 0; i < 8; ++i) v[it][i] = __builtin_nontemporal_load((const f32x4*)(sp + (size_t)(it * 8 + i) * J.ldw));
        if (col < 0) {
#pragma unroll
            for (int it = 0; it < 4; ++it)
#pragma unroll
                for (int i = 0; i < 8; ++i) v[it][i] = (f32x4){0.f, 0.f, 0.f, 0.f}; }
        if (J.g) {
#pragma unroll
            for (int it = 0; it < 4; ++it)
#pragma unroll
                for (int i = 0; i < 8; ++i) v[it][i] *= J.g[kb * 32 + it * 8 + i]; }
        bf16_t* dp = J.dst + (size_t)n * J.K + kb * 32;
#pragma unroll
        for (int jn = 0; jn < 4; ++jn)
#pragma unroll
            for (int it = 0; it < 4; ++it) { u32x4 w; w.x = cvt_pk_bf16(v[it][0][jn], v[it][1][jn]); w.y = cvt_pk_bf16(v[it][2][jn], v[it][3][jn]); w.z = cvt_pk_bf16(v[it][4][jn], v[it][5][jn]); w.w = cvt_pk_bf16(v[it][6][jn], v[it][7][jn]);
                *(u32x4*)(dp + (size_t)jn * J.K + it * 8) = w; }
    }
}

struct Params {
    const float* x; const float* meta; const float* g1; const float* wg1; const float* wu1; const float* wd1;
    const float* gm; const float* win; const float* qg; const float* kg; const float* cw; const float* cbias;
    const float* wa; const float* wc; const float* wo; const float* g2; const float* wg2; const float* wu2; const float* wd2;
    float* out; unsigned char* ws;
};

__device__ __forceinline__ int key_row(int b, int t) { return t < NMETA ? MMAIN + t : b * SEQ + t - NMETA; }

__device__ __forceinline__ void sincos_d(double a, float& s_out, float& c_out) {
    const double TWO_PI = 6.283185307179586476925286766559, INV = 0.15915494309189533576888376337251;
    const double n = rint(a * INV); double r = a - n * TWO_PI;
    const double y = 0.5 * r, y2 = y * y;
    double s = 1.0, c = 1.0, ts = 1.0, tc = 1.0;
#pragma unroll
    for (int k = 1; k <= 12; ++k) { tc *= -y2 / (double)((2 * k - 1) * (2 * k)); ts *= -y2 / (double)((2 * k) * (2 * k + 1)); c += tc; s += ts; }
    s *= y;
    s_out = (float)(2.0 * s * c); c_out = (float)(1.0 - 2.0 * s * s);
}

__device__ __forceinline__ void phase_prep(const Params& P, unsigned char* lds) {
    unsigned char* ws = P.ws;
    const int tid = threadIdx.x, lane = tid & 63, wave = tid >> 6;
    { float* rope = (float*)(ws + WS_ROPE);
      for (int idx = blockIdx.x * 512 + tid; idx < TT * 24; idx += gridDim.x * 512) {
          const int t = idx / 24, f = idx % 24; float inv;
          if (f < 16) inv = (float)exp2(-((double)(2 * f) / 32.0) * 18.931568569324174);
          else inv = (float)exp2(-((double)(2 * (f - 16)) / 16.0) * 18.931568569324174);
          const float ang = (float)t * inv; float s, c; sincos_d((double)ang, s, c);
          if (f < 16) { rope[t * 48 + f] = c; rope[t * 48 + 16 + f] = s; } else { rope[t * 48 + 32 + (f - 16)] = c; rope[t * 48 + 40 + (f - 16)] = s; }
      } }
    { bf16_t* HB = (bf16_t*)(ws + WS_HB); float* part = (float*)(ws + WS_PART); float* hmeta = (float*)(ws + WS_HMETA);
      for (int r = blockIdx.x * 8 + wave; r < MPAD; r += gridDim.x * 8) {
          const float* src = r < MMAIN ? P.x + (size_t)r * DM : (r < MMAIN + NMETA ? P.meta + (size_t)(r - MMAIN) * DM : nullptr);
          float ss = 0.f;
#pragma unroll
          for (int i = 0; i < 8; ++i) { const int c = i * 256 + lane * 4; f32x4 v = src ? __builtin_nontemporal_load((const f32x4*)(src + c)) : (f32x4){0.f, 0.f, 0.f, 0.f};
              ss += (v[0] * v[0] + v[1] * v[1]) + (v[2] * v[2] + v[3] * v[3]);
              u32x2 w; w.x = cvt_pk_bf16(v[0], v[1]); w.y = cvt_pk_bf16(v[2], v[3]); *(u32x2*)(HB + (size_t)r * DM + c) = w;
              if (r >= MMAIN) *(f32x4*)(hmeta + (size_t)(r - MMAIN) * DM + c) = v; }
#pragma unroll
          for (int o = 32; o >= 1; o >>= 1) ss += __shfl_xor(ss, o);
          if (lane < 32) part[(size_t)r * 32 + lane] = (lane == 0) ? ss : 0.f;
      } }
    {
        unsigned char* w = ws;
        const int lane_ = tid & 63, gw = blockIdx.x * 8 + wave, nw = gridDim.x * 8;
        constexpr int U0 = 44 * 64, U1 = U0 + 8 * 176, U2 = U1 + 44 * 64, U3 = U2 + 8 * 176, U4 = U3 + 39 * 64, U5 = U4 + 8 * 32, U6 = U5 + 8 * 32, U7 = U6 + 8 * 64;
        for (int u = gw; u < U7; u += nw) {
            if (u < U0)      { ConvJob J{P.wg1, P.wu1, P.g1, (bf16_t*)(w + WS_WGU), DFF, DM, 11264, 1}; convert_unit(J, u, lane_); }
            else if (u < U1) { ConvJob J{P.wd1, nullptr, nullptr, (bf16_t*)(w + WS_WD), DM, DFF, 2048, 0}; convert_unit(J, u - U0, lane_); }
            else if (u < U2) { ConvJob J{P.wg2, P.wu2, P.g2, (bf16_t*)(w + WS_WGU2), DFF, DM, 11264, 1}; convert_unit(J, u - U1, lane_); }
            else if (u < U3) { ConvJob J{P.wd2, nullptr, nullptr, (bf16_t*)(w + WS_WD2), DM, DFF, 2048, 0}; convert_unit(J, u - U2, lane_); }
            else if (u < U4) { ConvJob J{P.win, nullptr, P.gm, (bf16_t*)(w + WS_WIN), 9808, DM, NIN, 2}; convert_unit(J, u - U3, lane_); }
            else if (u < U5) { ConvJob J{P.wa, nullptr, nullptr, (bf16_t*)(w + WS_WA), DM, 1024, 2048, 0}; convert_unit(J, u - U4, lane_); }
            else if (u < U6) { ConvJob J{P.wc, nullptr, nullptr, (bf16_t*)(w + WS_WC), DM, 1024, 2048, 0}; convert_unit(J, u - U5, lane_); }
            else             { ConvJob J{P.wo, nullptr, nullptr, (bf16_t*)(w + WS_WO), DM, DM, 2048, 0}; convert_unit(J, u - U6, lane_); }
        }
    }
}

__device__ __forceinline__ void norm_rope16(u32x4& w0, u32x4& w1, const f32x4 (&gn)[4], const f32x4 (&cs)[8], int part) {
    float v[16];
    { float a[8], b[8]; unpack8(w0, a); unpack8(w1, b);
#pragma unroll
      for (int i = 0; i < 8; ++i) { v[i] = a[i]; v[8 + i] = b[i]; } }
    float ss = 0.f;
#pragma unroll
    for (int i = 0; i < 16; ++i) ss += v[i] * v[i];
    ss += __shfl_xor(ss, 1); ss += __shfl_xor(ss, 2); ss += __shfl_xor(ss, 4);
    const float rs = rsqrtf(ss * (1.0f / 128.0f) + EPS);
    float y[16];
#pragma unroll
    for (int i = 0; i < 16; ++i) y[i] = v[i] * rs * gn[i >> 2][i & 3];
#pragma unroll
    for (int i = 0; i < 16; ++i) { const float other = __shfl_xor(y[i], 1);
        if (part < 2) { const float c = cs[i >> 2][i & 3], sn = cs[4 + (i >> 2)][i & 3];
            y[i] = (part == 0) ? (y[i] * c - other * sn) : (y[i] * c + other * sn); } }
    { float a[8], b[8];
#pragma unroll
      for (int i = 0; i < 8; ++i) { a[i] = y[i]; b[i] = y[8 + i]; }
      w0 = pack8(a); w1 = pack8(b); }
}
__device__ __forceinline__ void rope_idx16(u32x4& w0, u32x4& w1, const f32x4 (&ci)[4]  ) {
    float a[8], b[8]; unpack8(w0, a); unpack8(w1, b);
    float r1[8], r2[8];
#pragma unroll
    for (int i = 0; i < 8; ++i) { const float c = ci[i >> 2][i & 3], sn = ci[2 + (i >> 2)][i & 3]; r1[i] = a[i] * c - b[i] * sn; r2[i] = b[i] * c + a[i] * sn; }
    w0 = pack8(r1); w1 = pack8(r2);
}
__device__ __forceinline__ void phase_post(const Params& P, unsigned char* lds) {
    unsigned char* ws = P.ws;
    bf16_t* Z1 = (bf16_t*)(ws + WS_Z1); bf16_t* XCC = (bf16_t*)(ws + WS_XCC); bf16_t* BB = (bf16_t*)(ws + WS_BB); bf16_t* HB = (bf16_t*)(ws + WS_HB);
    bf16_t* VT = (bf16_t*)(ws + WS_VT); const float* rope = (const float*)(ws + WS_ROPE);
    const int tid = threadIdx.x, lane = tid & 63, wave = tid >> 6;
    bf16_t* vt_l = (bf16_t*)lds;
    float* tq = (float*)(lds + 16384); float* tk = tq + 128; float* tcw = tk + 128; float* tcb = tcw + 3072;
    for (int i = tid; i < 128 + 128 + 3072 + 1024; i += 512) tq[i] = i < 128 ? P.qg[i] : (i < 256 ? P.kg[i - 128] : (i < 3328 ? P.cw[i - 256] : P.cbias[i - 3328]));
    __syncthreads();
    for (int blk = blockIdx.x; blk < 513; blk += gridDim.x) {
        const bool mblk = (blk == 512);
        const int b = blk >> 6, j = blk & 63;
        const int nrows = mblk ? 16 : 32, rbase = mblk ? MMAIN : b * SEQ + j * 32, t0 = mblk ? 0 : j * 32 + NMETA;
        for (int rl = wave; rl < nrows; rl += 8) {
            const int r = rbase + rl, t = t0 + rl; const float* rt = rope + (size_t)t * 48;
            bf16_t* zr = Z1 + (size_t)r * LDZ;
            bf16_t* qp = zr + 16 * lane; bf16_t* kp = zr + 1024 + 16 * (lane & 15); bf16_t* ip = zr + 1536 + 16 * lane; bf16_t* jp = zr + 2560 + 16 * (lane & 3);
            u32x4 q0 = *(const u32x4*)qp, q1 = *(const u32x4*)(qp + 8), k0 = *(const u32x4*)kp, k1 = *(const u32x4*)(kp + 8);
            u32x4 i0 = *(const u32x4*)ip, i1 = *(const u32x4*)(ip + 8), j0 = *(const u32x4*)jp, j1 = *(const u32x4*)(jp + 8);
            const u32x4 vv = *(const u32x4*)(zr + 1280 + (lane & 31) * 8);
            f32x4 cs[8], ci[4];
#pragma unroll
            for (int i = 0; i < 8; ++i) cs[i] = *(const f32x4*)(rt + 4 * i);
#pragma unroll
            for (int i = 0; i < 4; ++i) ci[i] = *(const f32x4*)(rt + 32 + 4 * i);
            if (!mblk) {
                const int c = lane * 16;
                const int sidx = r & (SEQ - 1);
                const int r1 = sidx >= 1 ? r - 1 : MMAIN + 15, r2 = sidx >= 2 ? r - 2 : MMAIN + 14 + sidx;
                u32x4 x0[2], x1[2], x2[2], bv[2]; f32x4 cw0[4], cw1[4], cw2[4], cb[4];
#pragma unroll
                for (int hq = 0; hq < 2; ++hq) { x0[hq] = *(const u32x4*)(XCC + (size_t)r * LDX + c + hq * 8); x1[hq] = *(const u32x4*)(XCC + (size_t)r1 * LDX + c + hq * 8);
                    x2[hq] = *(const u32x4*)(XCC + (size_t)r2 * LDX + c + hq * 8); bv[hq] = *(const u32x4*)(BB + (size_t)r * LDX + c + hq * 8); }
#pragma unroll
                for (int i = 0; i < 4; ++i) { cw0[i] = *(const f32x4*)(tcw + c + 4 * i); cw1[i] = *(const f32x4*)(tcw + 1024 + c + 4 * i); cw2[i] = *(const f32x4*)(tcw + 2048 + c + 4 * i); cb[i] = *(const f32x4*)(tcb + c + 4 * i); }
#pragma unroll
                for (int hq = 0; hq < 2; ++hq) { float a0[8], a1[8], a2[8], ab[8], o[8];
                    unpack8(x0[hq], a0); unpack8(x1[hq], a1); unpack8(x2[hq], a2); unpack8(bv[hq], ab);
#pragma unroll
                    for (int i = 0; i < 8; ++i) { const int q4 = hq * 2 + (i >> 2), e = i & 3;
                        const float y = cw0[q4][e] * a2[i] + cw1[q4][e] * a1[i] + cw2[q4][e] * a0[i] + cb[q4][e]; o[i] = ab[i] * y; }
                    *(u32x4*)(BB + (size_t)r * LDX + c + hq * 8) = pack8(o); }
            }
            f32x4 gq[4], gk[4];
#pragma unroll
            for (int i = 0; i < 4; ++i) { gq[i] = *(const f32x4*)(tq + (lane & 7) * 16 + 4 * i); gk[i] = *(const f32x4*)(tk + (lane & 7) * 16 + 4 * i); }
            norm_rope16(q0, q1, gq, cs, lane & 7);
            norm_rope16(k0, k1, gk, cs, lane & 7);
            rope_idx16(i0, i1, ci);
            const u32x4 j0raw = j0, j1raw = j1;
            rope_idx16(j0, j1, ci);
            *(u32x4*)qp = q0; *(u32x4*)(qp + 8) = q1;
            if (lane < 16) { *(u32x4*)kp = k0; *(u32x4*)(kp + 8) = k1; }
            if ((lane & 3) == 0) { *(u32x4*)ip = i0; *(u32x4*)(ip + 8) = i1; }
            if (lane == 0) { *(u32x4*)jp = j0; *(u32x4*)(jp + 8) = j1; }
            if (lane < 4) {
                const int half = lane >> 1, kk0 = 2 * (lane & 1);
                const int bb0 = mblk ? 0 : b, bb1 = mblk ? NBATCH : b + 1;
                for (int bb = bb0; bb < bb1; ++bb) {
                    unsigned char* kt = ws + WS_KI2 + ((size_t)bb * 65 + (t >> 5)) * 4096 + (half * 32 + (t & 31)) * 16;
                    *(u32x4*)(kt + kk0 * 1024) = (lane == 0) ? j0 : j0raw; *(u32x4*)(kt + (kk0 + 1) * 1024) = (lane == 0) ? j1 : j1raw; }
            }
            if (lane < 32) *(u32x4*)(vt_l + rl * 256 + lane * 8) = vv;
        }
        __syncthreads();
        { const int gd = tid >> 1, half = tid & 1;
          if (half * 16 < nrows) {
              unsigned w[8];
#pragma unroll
              for (int pp = 0; pp < 8; ++pp) { unsigned lo, hi;
                  { const int p0 = 2 * pp, kk = 8 * ((p0 >> 2) & 1) + 4 * (p0 >> 3) + (p0 & 3); lo = vt_l[(half * 16 + kk) * 256 + gd]; }
                  { const int p1 = 2 * pp + 1, kk = 8 * ((p1 >> 2) & 1) + 4 * (p1 >> 3) + (p1 & 3); hi = vt_l[(half * 16 + kk) * 256 + gd]; }
                  w[pp] = lo | (hi << 16); }
              u32x4 w0 = {w[0], w[1], w[2], w[3]}, w1 = {w[4], w[5], w[6], w[7]};
              const int bb0 = mblk ? 0 : b, bb1 = mblk ? NBATCH : b + 1;
              const int tpos = t0 + half * 16;
              for (int bb = bb0; bb < bb1; ++bb) { bf16_t* d = VT + (((size_t)bb * 65 + (tpos >> 5)) * 256 + gd) * 32 + (tpos & 31); *(u32x4*)d = w0; *(u32x4*)(d + 8) = w1; }
          }
          if (!mblk && j == 63 && half == 0) { bf16_t* d = VT + (((size_t)b * 65 + 64) * 256 + gd) * 32 + 16; u32x4 z = {0u, 0u, 0u, 0u}; *(u32x4*)d = z; *(u32x4*)(d + 8) = z; }
        }
        __syncthreads();
    }
}

__device__ __forceinline__ unsigned ordered_key(float f) { const unsigned u = __float_as_uint(f); return u ^ ((u >> 31) ? 0xffffffffu : 0x80000000u); }
constexpr int ATT_SC_OFF = 0, ATT_BM_OFF = 133120, ATT_K_OFF = 0, ATT_V_OFF = 32768;
__device__ __forceinline__ void phase_attn(const Params& P, unsigned char* lds) {
    unsigned char* ws = P.ws;
    const bf16_t* Z1 = (const bf16_t*)(ws + WS_Z1); const bf16_t* VT = (const bf16_t*)(ws + WS_VT); bf16_t* AO = (bf16_t*)(ws + WS_XCC);
    const int tid = threadIdx.x, lane = tid & 63, wave = tid >> 6, lr = lane & 31, hh = lane >> 5;
    unsigned* scU = (unsigned*)(lds + ATT_SC_OFF); unsigned* bm = (unsigned*)(lds + ATT_BM_OFF);
    for (int idx = blockIdx.x; idx < 512; idx += gridDim.x) {
        const int b = idx & 7; const int j = idx < 256 ? 63 - (idx >> 3) : ((idx - 256) >> 3);
        const int s0 = j * 32, ntiles = j + 2;
        for (int pp = 0; pp < 2; ++pp) {
            const int p = wave * 2 + pp; const int sq = s0 + 2 * p + hh; const int rowq = b * SEQ + sq;
            bf16x8 Aq[4];
            { const int qa = s0 + 2 * p + ((lr >> 2) & 1), ha = (lr & 3) + 4 * (lr >> 3);
              const bf16_t* ap = Z1 + (size_t)(b * SEQ + qa) * LDZ + 1536 + ha * 64 + hh * 32;
#pragma unroll
              for (int kk = 0; kk < 4; ++kk) Aq[kk] = *(const bf16x8*)(ap + kk * 8); }
            float wv[16];
            { float a[8], c[8]; unpack8(*(const u32x4*)(Z1 + (size_t)rowq * LDZ + 2624), a); unpack8(*(const u32x4*)(Z1 + (size_t)rowq * LDZ + 2632), c);
#pragma unroll
              for (int i = 0; i < 8; ++i) { wv[i] = a[i]; wv[8 + i] = c[i]; } }
            unsigned* myrow = scU + (wave * 2 + hh) * TPAD + lr;
            bf16x8 B0[4], B1[4], B2[4], B3[4];
#define IDX_LOAD(BUF, tl) do { const int tc_ = (tl) < 64 ? (tl) : 64; const unsigned char* bp_ = ws + WS_KI2 + ((size_t)b * 65 + tc_) * 4096 + (hh * 32 + lr) * 16; \
                _Pragma("unroll") for (int kk = 0; kk < 4; ++kk) BUF[kk] = *(const bf16x8*)(bp_ + kk * 1024); } while (0)
#define IDX_TILE(BUF, tl) do { const int t_ = (tl) * 32 + lr; f32x16 acc_; \
                _Pragma("unroll") for (int i = 0; i < 16; ++i) acc_[i] = 0.f; \
                _Pragma("unroll") for (int kk = 0; kk < 4; ++kk) acc_ = __builtin_amdgcn_mfma_f32_32x32x16_bf16(Aq[kk], BUF[kk], acc_, 0, 0, 0); \
                IDX_LOAD(BUF, (tl) + 4); \
                float sc_ = 0.f, sd_ = 0.f; \
                _Pragma("unroll") for (int i = 0; i < 16; i += 2) { sc_ += wv[i] * __int_as_float(max(__float_as_int(acc_[i]), 0)); sd_ += wv[i + 1] * __int_as_float(max(__float_as_int(acc_[i + 1]), 0)); } \
                sc_ += sd_; \
                myrow[(tl) * 32] = (t_ <= sq + NMETA) ? ordered_key(sc_) : 0u; } while (0)
            IDX_LOAD(B0, 0); IDX_LOAD(B1, 1); IDX_LOAD(B2, 2); IDX_LOAD(B3, 3);
            for (int tile = 0; tile < ntiles; tile += 4) {
                IDX_TILE(B0, tile);
                if (tile + 1 < ntiles) IDX_TILE(B1, tile + 1);
                if (tile + 2 < ntiles) IDX_TILE(B2, tile + 2);
                if (tile + 3 < ntiles) IDX_TILE(B3, tile + 3);
            }
#undef IDX_LOAD
#undef IDX_TILE
            const int nch = (ntiles + 7) >> 3;
            for (int tile = ntiles; tile < nch * 8 && tile < 65; ++tile) myrow[tile * 32] = 0u;
            unsigned key[72];
#pragma unroll
            for (int ch = 0; ch < 9; ++ch) {
                if (ch < nch) {
#pragma unroll
                    for (int jj = 0; jj < 8; ++jj) { const int jx = ch * 8 + jj; key[jx] = (jx < 65) ? myrow[jx * 32] : 0u; }
                } else {
#pragma unroll
                    for (int jj = 0; jj < 8; ++jj) key[ch * 8 + jj] = 0u;
                }
            }
            unsigned prefix = 0u;
            for (int bit = 31; bit >= 8; --bit) {
                const unsigned cand = prefix | (1u << bit); const int c31 = (int)(cand >> 1);
                int lt0 = 0, lt1 = 0;
#pragma unroll
                for (int ch = 0; ch < 9; ++ch) {
                    if (ch < nch) {
#pragma unroll
                        for (int jj = 0; jj < 8; jj += 2) { lt0 += (int)((unsigned)((int)(key[ch * 8 + jj] >> 1) - c31) >> 31); lt1 += (int)((unsigned)((int)(key[ch * 8 + jj + 1] >> 1) - c31) >> 31); }
                    }
                }
                int cnt = nch * 8 - (lt0 + lt1);
                cnt += __builtin_amdgcn_update_dpp(0, cnt, 0xB1, 0xF, 0xF, true);
                cnt += __builtin_amdgcn_update_dpp(0, cnt, 0x4E, 0xF, 0xF, true);
                cnt += __builtin_amdgcn_update_dpp(0, cnt, 0x141, 0xF, 0xF, true);
                cnt += __builtin_amdgcn_update_dpp(0, cnt, 0x140, 0xF, 0xF, true);
                cnt += __shfl_xor(cnt, 16);
                if (cnt >= 256) prefix = cand;
            }
            const unsigned thr = prefix > 1u ? prefix : 1u;
#pragma unroll
            for (int ch = 0; ch < 9; ++ch) {
                if (ch < nch) {
#pragma unroll
                    for (int jj = 0; jj < 8; ++jj) { const int jx = ch * 8 + jj;
                        if (jx < 65) { const unsigned long long bal = __ballot(key[jx] >= thr);
                            const unsigned word = hh ? (unsigned)(bal >> 32) : (unsigned)bal;
                            if (lr == 0) bm[(2 * p + hh) * 65 + jx] = word; } }
                }
            }
        }
        __syncthreads();
        {
            const int g = wave >> 2;
            bf16x8 Qf[8];
            { const bf16_t* qp = Z1 + (size_t)(b * SEQ + s0 + lr) * LDZ + wave * 128 + hh * 8;
#pragma unroll
              for (int kk = 0; kk < 8; ++kk) Qf[kk] = *(const bf16x8*)(qp + kk * 16); }
#pragma unroll
            for (int kk = 0; kk < 8; ++kk) asm volatile("" :: "v"(Qf[kk]));
            f32x16 o[4];
#pragma unroll
            for (int d = 0; d < 4; ++d)
#pragma unroll
                for (int i = 0; i < 16; ++i) o[d][i] = 0.f;
            float m = -1e30f, l = 0.f;
            const int kkey0 = tid >> 5, kch = tid & 31;
            const int vrow0 = tid >> 2, vc4 = tid & 3;
            u32x4 sKa[2], sVa[2], sKb[2], sVb[2];
#define ATT_LOAD(SK, SV, tile_) do { _Pragma("unroll") for (int i_ = 0; i_ < 2; ++i_) { const int key_ = kkey0 + 16 * i_; int t_ = (tile_) * 32 + key_; t_ = t_ < TT ? t_ : TT - 1; \
                SK[i_] = *(const u32x4*)(Z1 + (size_t)key_row(b, t_) * LDZ + 1024 + kch * 8); \
                SV[i_] = *(const u32x4*)(VT + (((size_t)b * 65 + (tile_)) * 256 + vrow0 + 128 * i_) * 32 + vc4 * 8); } } while (0)
#define ATT_STORE(SK, SV, buf_) do { _Pragma("unroll") for (int i_ = 0; i_ < 2; ++i_) { const int key_ = kkey0 + 16 * i_; \
                *(u32x4*)(lds + ATT_K_OFF + (buf_) * 16384 + key_ * 512 + (kch >> 4) * 256 + (((kch & 15) ^ (key_ & 15)) * 16)) = SK[i_]; \
                *(u32x4*)(lds + ATT_V_OFF + (buf_) * 20480 + (vrow0 + 128 * i_) * 80 + vc4 * 16) = SV[i_]; } } while (0)
            auto tile_body = [&](const int tile, const int buf) __attribute__((always_inline)) {
                f32x16 S;
#pragma unroll
                for (int i = 0; i < 16; ++i) S[i] = 0.f;
                const unsigned char* kb = lds + ATT_K_OFF + buf * 16384 + lr * 512 + g * 256;
#pragma unroll
                for (int kk = 0; kk < 8; ++kk) { const bf16x8 Kf = *(const bf16x8*)(kb + (((2 * kk + hh) ^ (lr & 15)) * 16)); S = __builtin_amdgcn_mfma_f32_32x32x16_bf16(Kf, Qf[kk], S, 0, 0, 0); }
                const unsigned bits2 = bm[lr * 65 + tile] >> (4 * hh);
                float mx = S[0];
#pragma unroll
                for (int i = 1; i < 16; ++i) mx = __builtin_fmaxf(mx, S[i]);
                mx *= 0.12751743f;
                mx = __builtin_fmaxf(mx, __shfl_xor(mx, 32));
                if (__any(mx > m)) { const float mn = __builtin_fmaxf(m, mx), al = __builtin_amdgcn_exp2f(m - mn);
#pragma unroll
                    for (int d = 0; d < 4; ++d)
#pragma unroll
                        for (int i = 0; i < 16; ++i) o[d][i] *= al;
                    l *= al; m = mn; }
                float pr[16];
#pragma unroll
                for (int i = 0; i < 16; ++i) { const int mk = __builtin_amdgcn_sbfe((int)bits2, (i & 3) + 8 * (i >> 2), 1);
                    const float e = __builtin_amdgcn_exp2f(__builtin_fmaf(S[i], 0.12751743f, -m));
                    pr[i] = __int_as_float(__float_as_int(e) & mk); l += pr[i]; }
                bf16x8 Pf[2];
#pragma unroll
                for (int s2 = 0; s2 < 2; ++s2) { u32x4 w; w.x = cvt_pk_bf16(pr[8 * s2 + 0], pr[8 * s2 + 1]); w.y = cvt_pk_bf16(pr[8 * s2 + 2], pr[8 * s2 + 3]);
                    w.z = cvt_pk_bf16(pr[8 * s2 + 4], pr[8 * s2 + 5]); w.w = cvt_pk_bf16(pr[8 * s2 + 6], pr[8 * s2 + 7]); Pf[s2] = __builtin_bit_cast(bf16x8, w); }
                const unsigned char* vb = lds + ATT_V_OFF + buf * 20480 + (g * 128 + lr) * 80 + hh * 16;
#pragma unroll
                for (int d = 0; d < 4; ++d)
#pragma unroll
                    for (int s2 = 0; s2 < 2; ++s2) { const bf16x8 Vf = *(const bf16x8*)(vb + d * 32 * 80 + s2 * 32); o[d] = __builtin_amdgcn_mfma_f32_32x32x16_bf16(Vf, Pf[s2], o[d], 0, 0, 0); }
            };
            ATT_LOAD(sKa, sVa, 0); ATT_STORE(sKa, sVa, 0);
            if (1 < ntiles) ATT_LOAD(sKb, sVb, 1);
            __syncthreads();
            for (int tile = 0; tile < ntiles; tile += 2) {
                if (tile + 2 < ntiles) ATT_LOAD(sKa, sVa, tile + 2);
                tile_body(tile, 0);
                if (tile + 1 < ntiles) ATT_STORE(sKb, sVb, 1);
                __syncthreads();
                if (tile + 1 >= ntiles) break;
                if (tile + 3 < ntiles) ATT_LOAD(sKb, sVb, tile + 3);
                tile_body(tile + 1, 1);
                if (tile + 2 < ntiles) ATT_STORE(sKa, sVa, 0);
                __syncthreads();
            }
#undef ATT_LOAD
#undef ATT_STORE
            l += __shfl_xor(l, 32);
            const float inv = 1.0f / l;
            bf16_t* op = AO + (size_t)(b * SEQ + s0 + lr) * LDX + wave * 128 + 4 * hh;
#pragma unroll
            for (int d = 0; d < 4; ++d)
#pragma unroll
                for (int q4 = 0; q4 < 4; ++q4) { u32x2 w; w.x = cvt_pk_bf16(o[d][4 * q4 + 0] * inv, o[d][4 * q4 + 1] * inv); w.y = cvt_pk_bf16(o[d][4 * q4 + 2] * inv, o[d][4 * q4 + 3] * inv);
                    *(u32x2*)(op + 32 * d + 8 * q4) = w; }
        }
        __syncthreads();
    }
}

#define XB_TMO      128
#define XB_XCNT(j)  (256  + 64 * (j))
#define XB_XSUB(j)  (1280 + 64 * (j))
#define XB_XGEN(j)  (2304 + 64 * (j))
#define XB_TOP      3328
#define XB_TOPGEN   3392
#define XCD_BAR_WORDS 3456
#define XB_SPIN_CAP (1u << 18)
__device__ __forceinline__ unsigned xb_ld(unsigned* p)              { return __hip_atomic_load(p, __ATOMIC_RELAXED, __HIP_MEMORY_SCOPE_AGENT); }
__device__ __forceinline__ unsigned xb_add(unsigned* p, unsigned v) { return __hip_atomic_fetch_add(p, v, __ATOMIC_RELAXED, __HIP_MEMORY_SCOPE_AGENT); }
__device__ __forceinline__ unsigned xb_xcc_id() { return (unsigned)__builtin_amdgcn_s_getreg((3 << 11) | 20) & 0xFu; }
#define XB_SPIN(cond, bar) do { unsigned _sp = 0; while (cond) { __builtin_amdgcn_s_sleep(1); \
    if ((++_sp & 255u) == 0u) { if (xb_ld(&(bar)[XB_TMO])) break; if (_sp > XB_SPIN_CAP) { atomicAdd(&(bar)[XB_TMO], 1u); break; } } } } while (0)
struct XcdBarrier { unsigned* bar; unsigned x; volatile PG8_LAS unsigned* st; };
__device__ __forceinline__ XcdBarrier xcd_barrier_post(unsigned* bar, volatile PG8_LAS unsigned* st) {
    XcdBarrier b; b.bar = bar; b.x = xb_xcc_id(); b.st = st;
    if (threadIdx.x == 0) (void)xb_add(&bar[XB_XCNT(b.x)], 1u);
    return b;
}
__device__ __forceinline__ void xcd_barrier_complete(unsigned* bar, unsigned x, unsigned& nloc, unsigned& nx) {
    const unsigned G = gridDim.x * gridDim.y * gridDim.z;
    unsigned sum, cnt, mine, sp = 0u;
    for (;;) {
        sum = 0u; cnt = 0u; mine = 0u;
#pragma unroll
        for (unsigned j = 0; j < 16; ++j) { const unsigned c = xb_ld(&bar[XB_XCNT(j)]); sum += c; cnt += (c > 0u) ? 1u : 0u; mine = (j == x) ? c : mine; }
        if (sum == G) break;
        __builtin_amdgcn_s_sleep(1);
        if ((++sp & 255u) == 0u) { if (xb_ld(&bar[XB_TMO])) break; if (sp > XB_SPIN_CAP) { atomicAdd(&bar[XB_TMO], 1u); break; } }
    }
    nloc = mine > 0u ? mine : 1u; nx = cnt > 0u ? cnt : 1u;
}
__device__ __forceinline__ void xcd_barrier(const XcdBarrier& b) {
    asm volatile("s_waitcnt vmcnt(0)" ::: "memory");
    __syncthreads();
    if (threadIdx.x == 0) {
        unsigned* bar = b.bar;
        __builtin_amdgcn_s_waitcnt(0);
        unsigned nloc = b.st[0], nx = b.st[1];
        if (nloc == 0u) { xcd_barrier_complete(bar, b.x, nloc, nx); b.st[0] = nloc; b.st[1] = nx; }
        const unsigned old = xb_add(&bar[XB_XSUB(b.x)], 1u);
        const unsigned gen = old / nloc;
        if (old == gen * nloc && nloc > 1u) {
            __builtin_amdgcn_fence(__ATOMIC_RELEASE, "agent");
            asm volatile("s_waitcnt vmcnt(0)" ::: "memory");
        }
        if (old + 1u == (gen + 1u) * nloc) {
            __builtin_amdgcn_fence(__ATOMIC_RELEASE, "agent");
            asm volatile("s_waitcnt vmcnt(0)" ::: "memory");
            const unsigned og = xb_add(&bar[XB_TOP], 1u);
            const unsigned tg = og / nx;
            if (og + 1u == (tg + 1u) * nx) xb_add(&bar[XB_TOPGEN], 1u);
            else XB_SPIN(xb_ld(&bar[XB_TOPGEN]) == tg, bar);
            __builtin_amdgcn_fence(__ATOMIC_ACQUIRE, "agent");
            xb_add(&bar[XB_XGEN(b.x)], 1u);
            asm volatile("s_waitcnt vmcnt(0)" ::: "memory");
        } else {
            XB_SPIN(xb_ld(&bar[XB_XGEN(b.x)]) == gen, bar);
            __builtin_amdgcn_fence(__ATOMIC_ACQUIRE, "agent");
            asm volatile("s_waitcnt vmcnt(0)" ::: "memory");
        }
    }
    __syncthreads();
}
__global__ void __launch_bounds__(512, 2) fwd_megakernel(Params P, int ph_lo, int ph_hi) {
    extern __shared__ __attribute__((aligned(16))) unsigned char lds[];
    cg::grid_group grid = cg::this_grid();
    unsigned char* ws = P.ws;
    PG8_LAS unsigned char* lds3 = (PG8_LAS unsigned char*)lds;
    const int G = gridDim.x, c = blockIdx.x;
    bf16_t* WGU2 = (bf16_t*)(ws + WS_WGU2); bf16_t* WD2 = (bf16_t*)(ws + WS_WD2);
    bf16_t* WGU = (bf16_t*)(ws + WS_WGU); bf16_t* WD = (bf16_t*)(ws + WS_WD); bf16_t* WIN = (bf16_t*)(ws + WS_WIN);
    bf16_t* WA = (bf16_t*)(ws + WS_WA); bf16_t* WC = (bf16_t*)(ws + WS_WC); bf16_t* WO = (bf16_t*)(ws + WS_WO);
    bf16_t* HB = (bf16_t*)(ws + WS_HB); bf16_t* ACT = (bf16_t*)(ws + WS_Z1); bf16_t* Z1 = (bf16_t*)(ws + WS_Z1);
    bf16_t* XCC = (bf16_t*)(ws + WS_XCC); bf16_t* BB = (bf16_t*)(ws + WS_BB); bf16_t* GG = (bf16_t*)(ws + WS_G);
    float* part0 = (float*)(ws + WS_PART); float* part1 = (float*)(ws + WS_PART + PART_SZ); float* part2 = (float*)(ws + WS_PART + 2 * PART_SZ);
    float* hmeta = (float*)(ws + WS_HMETA);
#define IN(k) (ph_lo <= (k) && (k) < ph_hi)
    volatile PG8_LAS unsigned* bst = (volatile PG8_LAS unsigned*)(lds3 + 147456);
    if (threadIdx.x == 0) { bst[0] = 0u; bst[1] = 0u; }
    __syncthreads();
    const XcdBarrier xbar = xcd_barrier_post((unsigned*)(ws + WS_BAR), bst);
    if (ph_hi < 0) grid.sync();
#define SEAM(k) do { if (IN(k) && IN((k) + 1)) xcd_barrier(xbar); } while (0)
    if (IN(0)) phase_prep(P, lds);
    SEAM(0);
    if (IN(1)) { pg8::Gemm g{HB, WGU, MMAIN, 11264, DM, DM, DM}; pg8::StaticOrder S; S.init(MMAIN, 11264, G, c); EpiGU E{ACT, part0, (PG8_LAS float*)(lds3 + 131072), -1}; pg8::gemm_phase(lds3, g, S, E);
        skinny16<true, 8>(HB + (size_t)MMAIN * DM, DM, WGU, DM, 44 * 8, lds, [&](const f32x4& a0, const f32x4& a1, int task, int n0, int r, int kq) {
#pragma unroll
            for (int j = 0; j < 4; ++j) { const int row = kq * 4 + j; const f32x4* pp = (const f32x4*)(part0 + (size_t)(MMAIN + row) * 32); float sm = 0.f;
#pragma unroll
                for (int i = 0; i < 8; ++i) { const f32x4 v = pp[i]; sm += (v[0] + v[1]) + (v[2] + v[3]); }
                const float rs = rsqrtf(sm * (1.0f / 2048.0f) + EPS), gv = a0[j] * rs, uv = a1[j] * rs;
                const float o = gv * sigmoidf_(gv) * uv;
                ACT[(size_t)(MMAIN + row) * DFF + (n0 >> 8) * 128 + (n0 & 127) + r] = (bf16_t)(cvt_pk_bf16(o, 0.f) & 0xffffu); }
        });
    }
    SEAM(1);
    if (IN(2)) { pg8::Gemm g{ACT, WD, MMAIN, 2048, DFF, DFF, DFF}; pg8::StaticOrder S; S.init(MMAIN, 2048, G, c);
        EpiRes E{HB, nullptr, HB, part1, 0.5f}; pg8::gemm_phase(lds3, g, S, E);
        float* partm = (float*)(ws + WS_PARTM);
        skinny16<false, 22>(ACT + (size_t)MMAIN * DFF, DFF, WD, DFF, 128, lds, [&](const f32x4& a0, const f32x4&, int task, int n0, int r, int kq) {
#pragma unroll
            for (int j = 0; j < 4; ++j) { const int row = kq * 4 + j; const float h = P.meta[(size_t)row * DM + n0 + r] + 0.5f * a0[j];
                HB[(size_t)(MMAIN + row) * DM + n0 + r] = (bf16_t)(cvt_pk_bf16(h, 0.f) & 0xffffu);
                float ss = h * h;
                ss += __int_as_float(__builtin_amdgcn_update_dpp(0, __float_as_int(ss), 0xB1, 0xF, 0xF, true));
                ss += __int_as_float(__builtin_amdgcn_update_dpp(0, __float_as_int(ss), 0x4E, 0xF, 0xF, true));
                ss += __int_as_float(__builtin_amdgcn_update_dpp(0, __float_as_int(ss), 0x141, 0xF, 0xF, true));
                ss += __int_as_float(__builtin_amdgcn_update_dpp(0, __float_as_int(ss), 0x140, 0xF, 0xF, true));
                if (r == 0) partm[row * 128 + task] = ss; }
        });
    }
    SEAM(2);
    if (IN(3)) { pg8::Gemm g{HB, WIN, MPAD, NIN, DM, DM, DM}; pg8::StaticOrder S; S.init(MPAD, NIN, G, c); EpiZ E{Z1, XCC, BB, GG, part1, (const float*)(ws + WS_PARTM), (PG8_LAS float*)(lds3 + 131072), -1}; pg8::gemm_phase(lds3, g, S, E); }
    SEAM(3);
    if (IN(4)) phase_post(P, lds);
    SEAM(4);
    if (IN(5)) phase_attn(P, lds);
    SEAM(5);
    if (IN(6)) { pg8::Gemm g{XCC, WA, MMAIN, 2048, 1024, LDX, 1024}; pg8::StaticOrder S; S.init(MMAIN, 2048, G, c); EpiGate E{GG, 0}; pg8::gemm_phase(lds3, g, S, E); }
    if (IN(7)) { pg8::Gemm g{BB, WC, MMAIN, 2048, 1024, LDX, 1024}; pg8::StaticOrder S; S.init(MMAIN, 2048, G, c); EpiGate E{GG, 1}; pg8::gemm_phase(lds3, g, S, E); }
    SEAM(7);
    if (IN(8)) { pg8::Gemm g{GG, WO, MMAIN, 2048, DM, LDG, DM}; pg8::StaticOrder S; S.init(MMAIN, 2048, G, c);
        EpiRes E{HB, nullptr, HB, part2, 1.0f}; pg8::gemm_phase(lds3, g, S, E); }
    SEAM(8);
    if (IN(9)) { pg8::Gemm g{HB, WGU2, MMAIN, 11264, DM, DM, DM}; pg8::StaticOrder S; S.init(MMAIN, 11264, G, c); EpiGU E{ACT, part2, (PG8_LAS float*)(lds3 + 131072), -1}; pg8::gemm_phase(lds3, g, S, E); }
    SEAM(9);
    if (IN(10)) { pg8::Gemm g{ACT, WD2, MMAIN, 2048, DFF, DFF, DFF}; pg8::StaticOrder S; S.init(MMAIN, 2048, G, c);
        EpiRes E{HB, P.out, nullptr, nullptr, 0.5f}; pg8::gemm_phase(lds3, g, S, E); }
#undef IN
#undef SEAM
}

extern "C" void kernel_launch(void* const* d_in, const int* in_sizes, int n_in, void* d_out, int out_size, void* d_ws, size_t ws_size, hipStream_t stream) {
    static int grid = 0;
    if (grid == 0) {
        if (n_in != 19 || ws_size < WS_END) { fprintf(stderr, "kernel_launch: unexpected n_in %d / ws_size %zu (need %zu)\n", n_in, ws_size, (size_t)WS_END); grid = -1; return; }
        int dev = 0, cus = 0, per_cu = 0;
        hipGetDevice(&dev); hipDeviceGetAttribute(&cus, hipDeviceAttributeMultiprocessorCount, dev);
        if (hipFuncSetAttribute((const void*)fwd_megakernel, hipFuncAttributeMaxDynamicSharedMemorySize, LDS_BYTES) != hipSuccess) { fprintf(stderr, "kernel_launch: hipFuncSetAttribute failed\n"); grid = -1; return; }
        if (hipOccupancyMaxActiveBlocksPerMultiprocessor(&per_cu, (const void*)fwd_megakernel, 512, LDS_BYTES) != hipSuccess || per_cu < 1) { fprintf(stderr, "kernel_launch: occupancy query says %d\n", per_cu); per_cu = 1; }
        (void)hipGetLastError();
        grid = cus;
    }
    if (grid < 0) return;
    if (hipMemsetAsync((char*)d_ws + WS_BAR, 0, 16384, stream) != hipSuccess) { fprintf(stderr, "kernel_launch: memset failed\n"); return; }
    Params p{};
    p.x = (const float*)d_in[0]; p.meta = (const float*)d_in[1]; p.g1 = (const float*)d_in[2]; p.wg1 = (const float*)d_in[3]; p.wu1 = (const float*)d_in[4]; p.wd1 = (const float*)d_in[5];
    p.gm = (const float*)d_in[6]; p.win = (const float*)d_in[7]; p.qg = (const float*)d_in[8]; p.kg = (const float*)d_in[9]; p.cw = (const float*)d_in[10]; p.cbias = (const float*)d_in[11];
    p.wa = (const float*)d_in[12]; p.wc = (const float*)d_in[13]; p.wo = (const float*)d_in[14]; p.g2 = (const float*)d_in[15]; p.wg2 = (const float*)d_in[16]; p.wu2 = (const float*)d_in[17]; p.wd2 = (const float*)d_in[18];
    p.out = (float*)d_out; p.ws = (unsigned char*)d_ws;
    int lo = 0, hi = 11;
    void* args[] = {&p, &lo, &hi};
    hipError_t e = hipLaunchCooperativeKernel((const void*)fwd_megakernel, dim3(grid), dim3(512), args, LDS_BYTES, stream);
    if (e != hipSuccess) fprintf(stderr, "cooperative launch failed: %s (grid %d)\n", hipGetErrorString(e), grid);
}
```

```cpp
#include <hip/hip_runtime.h>
#include <hip/hip_cooperative_groups.h>
#include <cstdio>
namespace cg = cooperative_groups;

typedef unsigned short bf16_t;
typedef short bf16x8 __attribute__((ext_vector_type(8)));
typedef float f32x4 __attribute__((ext_vector_type(4)));
typedef float f32x16 __attribute__((ext_vector_type(16)));
typedef unsigned u32x4 __attribute__((ext_vector_type(4)));
typedef unsigned u32x2 __attribute__((ext_vector_type(2)));

constexpr int DM = 2048, NBATCH = 8, SEQ = 2048, NMETA = 16, TT = 2064, DFF = 5632;
constexpr int MMAIN = 16384, MPAD = 16640;
constexpr int LDZ = 2816, LDX = 1024, LDG = 4096;
constexpr int NIN = 9984;
constexpr int TPAD = 2080;
constexpr float EPS = 1e-6f;
constexpr int LDS_BYTES = 147472;

constexpr size_t WS_WGU = 0;
constexpr size_t WS_WD = WS_WGU + (size_t)11264 * 2048 * 2;
constexpr size_t WS_XCC = WS_WGU;
constexpr size_t WS_BB = WS_XCC + (size_t)MPAD * LDX * 2;
constexpr size_t WS_WGU2 = WS_WD + (size_t)2048 * 5632 * 2;
constexpr size_t WS_WD2 = WS_WGU2 + (size_t)11264 * 2048 * 2;
constexpr size_t WS_WIN = WS_WD2 + (size_t)2048 * 5632 * 2;
constexpr size_t WS_WA = WS_WIN + (size_t)NIN * 2048 * 2;
constexpr size_t WS_WC = WS_WA + (size_t)2048 * 1024 * 2;
constexpr size_t WS_WO = WS_WC + (size_t)2048 * 1024 * 2;
constexpr size_t WS_HB = WS_WO + (size_t)2048 * 2048 * 2;
constexpr size_t WS_Z1 = WS_HB + (size_t)MPAD * 2048 * 2;
constexpr size_t WS_G = WS_Z1 + (size_t)MPAD * LDZ * 2;
constexpr size_t WS_VT = WS_G + (size_t)MPAD * LDG * 2;
constexpr size_t WS_PART = WS_VT + (size_t)NBATCH * 2 * 128 * TPAD * 2;
constexpr size_t PART_SZ = (size_t)MPAD * 32 * 4;
constexpr size_t WS_HMETA = WS_PART + 3 * PART_SZ;
constexpr size_t WS_ROPE = WS_HMETA + (size_t)256 * 2048 * 4;
constexpr size_t WS_PARTM = WS_ROPE + (size_t)TT * 48 * 4;
constexpr size_t WS_BAR = WS_PARTM + 16 * 128 * 4;
constexpr size_t WS_KI2 = WS_BAR + 16384;
constexpr size_t WS_END = WS_KI2 + (size_t)NBATCH * 65 * 4096;
static_assert(WS_Z1 + (size_t)MPAD * DFF * 2 <= WS_VT, "act alias");
static_assert(WS_BB + (size_t)MPAD * LDX * 2 <= WS_WGU2, "xcc/bb alias");
static_assert(WS_END <= (size_t)536870912, "workspace");

__device__ __forceinline__ unsigned cvt_pk_bf16(float lo, float hi) { unsigned r; asm volatile("v_cvt_pk_bf16_f32 %0, %1, %2" : "=v"(r) : "v"(lo), "v"(hi)); return r; }
__device__ __forceinline__ float bf_lo(unsigned w) { return __uint_as_float(w << 16); }
__device__ __forceinline__ float bf_hi(unsigned w) { return __uint_as_float(w & 0xffff0000u); }
__device__ __forceinline__ float bf2f(bf16_t b) { return __uint_as_float(((unsigned)b) << 16); }
__device__ __forceinline__ float sigmoidf_(float x) { return __builtin_amdgcn_rcpf(1.0f + __expf(-x)); }
__device__ __forceinline__ void unpack8(const u32x4 w, float (&f)[8]) {
    f[0] = bf_lo(w.x); f[1] = bf_hi(w.x); f[2] = bf_lo(w.y); f[3] = bf_hi(w.y); f[4] = bf_lo(w.z); f[5] = bf_hi(w.z); f[6] = bf_lo(w.w); f[7] = bf_hi(w.w); }
__device__ __forceinline__ u32x4 pack8(const float (&f)[8]) { u32x4 w; w.x = cvt_pk_bf16(f[0], f[1]); w.y = cvt_pk_bf16(f[2], f[3]); w.z = cvt_pk_bf16(f[4], f[5]); w.w = cvt_pk_bf16(f[6], f[7]); return w; }
__device__ __forceinline__ void rstd8(const float* part, int row0, int fq, float (&rs)[8]) {
    f32x4 v[8][2];
#pragma unroll
    for (int k = 0; k < 8; ++k) { const f32x4* p = (const f32x4*)(part + (size_t)(row0 + (k >> 2) * 128 + (k & 3) * 16) * 32 + fq * 8); v[k][0] = p[0]; v[k][1] = p[1]; }
#pragma unroll
    for (int k = 0; k < 8; ++k) { float s = ((v[k][0][0] + v[k][0][1]) + (v[k][0][2] + v[k][0][3])) + ((v[k][1][0] + v[k][1][1]) + (v[k][1][2] + v[k][1][3]));
        s += __shfl_xor(s, 16); s += __shfl_xor(s, 32); rs[k] = rsqrtf(s * (1.0f / 2048.0f) + EPS); }
}

namespace pg8 {
#define PG8_LAS __attribute__((address_space(3)))
constexpr int BM = 256, BK = 64, HALF = 128, HTB = HALF * BK * 2, STAGE_BYTES = 8 * HTB, NXCD = 8, WGM = 4;
__host__ __device__ __forceinline__ int lds_byte(int r, int c) { const int st = (r >> 4) * 2 + (c >> 5), rr = r & 15, cc = c & 31, ob = rr * 64 + cc * 2; return st * 1024 + (ob ^ (((ob >> 9) & 1) << 5)); }
__host__ __device__ __forceinline__ void stage_rc(int b, int& R, int& C) { const int st = b / 1024, sb = b % 1024, swz = sb ^ (((sb >> 9) & 1) << 5); R = (st >> 1) * 16 + swz / 64; C = (st & 1) * 32 + (swz % 64) / 2; }
__host__ __device__ __forceinline__ int perm32(int rho) { const int n = rho >> 4, i = rho & 15; return 8 * (i >> 2) + 4 * n + (i & 3); }
struct Unit { int pm, pn; };
struct Gemm { const bf16_t* A; const bf16_t* Bt; int M, N, K, lda, ldb; };
struct StaticOrder {
    int nM, nN, nwg, G, c;
    __device__ void init(int M, int N, int G_, int c_) { nM = M / BM; nN = N / BM; nwg = nM * nN; G = G_; c = c_; }
    __device__ bool next(int i, Unit& u) const {
        const long L = (long)i * G + c; if (L >= nwg) return false;
        int wgid = (int)L; { const int q = nwg / NXCD, r = nwg % NXCD, xcd = wgid % NXCD, off = wgid / NXCD; wgid = (xcd < r ? xcd * (q + 1) : r * (q + 1) + (xcd - r) * q) + off; }
        const int nig = WGM * nN, gid = wgid / nig, fm = gid * WGM, gsz = (nM - fm) < WGM ? (nM - fm) : WGM;
        u.pm = fm + ((wgid % nig) % gsz); u.pn = (wgid % nig) / gsz; return true;
    }
};

template <class Epi>
__device__ __forceinline__ void gemm_phase(PG8_LAS unsigned char* lds, const Gemm g, const StaticOrder& S, const Epi& E) {
    const int tid = threadIdx.x, wid = __builtin_amdgcn_readfirstlane(tid >> 6), lane = tid & 63, wr = wid >> 2, wc = wid & 3, fr = lane & 15, fq = lane >> 4;
    const int K = g.K, nt = K / BK;
    unsigned voffA[2], voffB[2];
#pragma unroll
    for (int i = 0; i < 2; ++i) { int R, C; stage_rc(tid * 16 + i * 8192, R, C); const int Rb = Epi::PERM ? ((R & ~31) + perm32(R & 31)) : R;
        voffA[i] = (unsigned)(R * g.lda + C) * 2u; voffB[i] = (unsigned)(Rb * g.ldb + C) * 2u; }
    const size_t kstep = (size_t)(BK * 2);
    const size_t hstepA = (size_t)HALF * g.lda * 2, hstepB = (size_t)HALF * g.ldb * 2;
    const size_t tstepA = 2 * hstepA, tstepB = 2 * hstepB;
    const unsigned ldsw = (unsigned)wid * 1024u;
    const int aoff = lds_byte(wr * 64 + fr, fq * 8), boff = lds_byte(wc * 32 + fr, fq * 8);
#define PG8_SA(b, h) (((b) * 2 + (h)) * HTB)
#define PG8_SB(b, h) ((4 + (b) * 2 + (h)) * HTB)
#define PG8_STAGE(bufoff, gbase, voff) do { _Pragma("unroll") for (int _i = 0; _i < 2; ++_i) \
        __builtin_amdgcn_global_load_lds((const unsigned*)((const char*)(gbase) + (voff)[_i]), (PG8_LAS unsigned*)(lds + (bufoff) + ldsw + _i * 8192), 16, 0, 0); } while (0)
#define PG8_LDA(dst, b, h) do { _Pragma("unroll") for (int m = 0; m < 4; ++m) _Pragma("unroll") for (int k = 0; k < 2; ++k) dst[m][k] = *(const PG8_LAS bf16x8*)(lds + PG8_SA(b, h) + aoff + m * 2048 + k * 1024); } while (0)
#define PG8_LDB(dst, b, h) do { _Pragma("unroll") for (int n = 0; n < 2; ++n) _Pragma("unroll") for (int k = 0; k < 2; ++k) dst[n][k] = *(const PG8_LAS bf16x8*)(lds + PG8_SB(b, h) + boff + n * 2048 + k * 1024); } while (0)
#define PG8_MMA(ai, bj, At, Bt) do { __builtin_amdgcn_s_setprio(1); _Pragma("unroll") for (int m = 0; m < 4; ++m) _Pragma("unroll") for (int n = 0; n < 2; ++n) _Pragma("unroll") for (int k = 0; k < 2; ++k) \
        acc[ai][bj][m][n] = __builtin_amdgcn_mfma_f32_16x16x32_bf16(Bt[n][k], At[m][k], acc[ai][bj][m][n], 0, 0, 0); __builtin_amdgcn_s_setprio(0); } while (0)
#define PG8_WAIT_V(n) asm volatile("s_waitcnt vmcnt(" #n ")" ::: "memory")
#define PG8_WAIT_L(n) asm volatile("s_waitcnt lgkmcnt(" #n ")" ::: "memory")
#define PG8_BAR __builtin_amdgcn_s_barrier()
#define PG8_SCHED __builtin_amdgcn_sched_barrier(0)
    Unit cur, nxt; int ui = 0;
    if (!S.next(0, cur)) return;
    f32x4 acc[2][2][4][2];
#pragma unroll
    for (int a = 0; a < 2; ++a)
#pragma unroll
        for (int b = 0; b < 2; ++b)
#pragma unroll
            for (int m = 0; m < 4; ++m)
#pragma unroll
                for (int n = 0; n < 2; ++n) acc[a][b][m][n] = (f32x4){0.f, 0.f, 0.f, 0.f};
    bf16x8 At[4][2], B0[2][2], B1[2][2];
    const char* cA = (const char*)g.A + (size_t)cur.pm * tstepA; const char* cB = (const char*)g.Bt + (size_t)cur.pn * tstepB;
    PG8_STAGE(PG8_SB(0, 0), cB, voffB); PG8_STAGE(PG8_SA(0, 0), cA, voffA); PG8_STAGE(PG8_SB(0, 1), cB + hstepB, voffB); PG8_STAGE(PG8_SA(0, 1), cA + hstepA, voffA);
    if (wr == 1) PG8_BAR;
    PG8_WAIT_V(4); PG8_BAR;
    PG8_STAGE(PG8_SB(1, 0), cB + kstep, voffB); PG8_STAGE(PG8_SA(1, 0), cA + kstep, voffA); PG8_STAGE(PG8_SB(1, 1), cB + hstepB + kstep, voffB);
    PG8_WAIT_V(6); PG8_BAR;
    for (;;) {
        const bool has_next = S.next(ui + 1, nxt);
        const char* nA = has_next ? (const char*)g.A + (size_t)nxt.pm * tstepA : cA; const char* nB = has_next ? (const char*)g.Bt + (size_t)nxt.pn * tstepB : cB;
        for (int t = 0; t < nt; t += 2) {
            const bool last = (t == nt - 2);
            const char* a1 = cA + (size_t)(t + 1) * kstep;
            const char* a2 = last ? nA : cA + (size_t)(t + 2) * kstep; const char* b2 = last ? nB : cB + (size_t)(t + 2) * kstep;
            const char* a3 = a2 + kstep; const char* b3 = b2 + kstep;
            PG8_LDB(B0, 0, 0); PG8_SCHED; PG8_LDA(At, 0, 0); PG8_STAGE(PG8_SA(1, 1), a1 + hstepA, voffA);
            PG8_WAIT_L(8); PG8_BAR; PG8_WAIT_L(0); PG8_MMA(0, 0, At, B0); PG8_BAR; PG8_SCHED;
            PG8_LDB(B1, 0, 1); PG8_STAGE(PG8_SB(0, 0), b2, voffB);
            PG8_BAR; PG8_WAIT_L(0); PG8_MMA(0, 1, At, B1); PG8_BAR;
            PG8_LDA(At, 0, 1); PG8_STAGE(PG8_SA(0, 0), a2, voffA);
            PG8_BAR; PG8_WAIT_L(0); PG8_MMA(1, 0, At, B0); PG8_BAR; PG8_SCHED;
            PG8_STAGE(PG8_SB(0, 1), b2 + hstepB, voffB);
            PG8_WAIT_V(6); PG8_BAR; PG8_MMA(1, 1, At, B1); PG8_BAR;
            PG8_LDB(B0, 1, 0); PG8_SCHED; PG8_LDA(At, 1, 0); PG8_STAGE(PG8_SA(0, 1), a2 + hstepA, voffA);
            PG8_WAIT_L(8); PG8_BAR; PG8_WAIT_L(0); PG8_MMA(0, 0, At, B0); PG8_BAR; PG8_SCHED;
            PG8_LDB(B1, 1, 1); PG8_STAGE(PG8_SB(1, 0), b3, voffB);
            PG8_BAR; PG8_WAIT_L(0); PG8_MMA(0, 1, At, B1); PG8_BAR;
            PG8_LDA(At, 1, 1); PG8_STAGE(PG8_SA(1, 0), a3, voffA);
            PG8_BAR; PG8_WAIT_L(0); PG8_MMA(1, 0, At, B0); PG8_BAR; PG8_SCHED;
            PG8_STAGE(PG8_SB(1, 1), b3 + hstepB, voffB);
            PG8_WAIT_V(6); PG8_BAR; PG8_MMA(1, 1, At, B1); PG8_BAR;
        }
        E(acc, cur, wr, wc, fr, fq);
        if (!has_next) break;
#pragma unroll
        for (int a = 0; a < 2; ++a)
#pragma unroll
            for (int b = 0; b < 2; ++b)
#pragma unroll
                for (int m = 0; m < 4; ++m)
#pragma unroll
                    for (int n = 0; n < 2; ++n) acc[a][b][m][n] = (f32x4){0.f, 0.f, 0.f, 0.f};
        cur = nxt; cA = nA; cB = nB; ++ui;
    }
    PG8_WAIT_V(0);
    if (wr == 0) PG8_BAR;
    PG8_BAR;
#undef PG8_SA
#undef PG8_SB
#undef PG8_STAGE
#undef PG8_LDA
#undef PG8_LDB
#undef PG8_MMA
#undef PG8_WAIT_V
#undef PG8_WAIT_L
#undef PG8_BAR
#undef PG8_SCHED
}
}

struct EpiGU {
    static constexpr bool PERM = true;
    bf16_t* act; const float* part; PG8_LAS float* rs_lds; mutable int cached_pm;
    __device__ __forceinline__ void operator()(const f32x4 (&acc)[2][2][4][2], const pg8::Unit& u, int wr, int wc, int fr, int fq) const {
        const int row0 = u.pm * 256 + wr * 64 + fr, col0 = u.pn * 128 + wc * 32 + 8 * fq;
        float rsv[8]; PG8_LAS float* mine = rs_lds + (wr * 4 + wc) * 512 + fq * 16 + fr;
        if (u.pm != cached_pm) { rstd8(part, row0, fq, rsv);
#pragma unroll
            for (int k = 0; k < 8; ++k) mine[k * 64] = rsv[k];
            cached_pm = u.pm; }
        else {
#pragma unroll
            for (int k = 0; k < 8; ++k) rsv[k] = mine[k * 64]; }
#pragma unroll
        for (int ai = 0; ai < 2; ++ai)
#pragma unroll
            for (int m = 0; m < 4; ++m) {
                const int r = row0 + ai * 128 + m * 16; const float rs = rsv[ai * 4 + m];
                float o[8];
#pragma unroll
                for (int n = 0; n < 2; ++n)
#pragma unroll
                    for (int i = 0; i < 4; ++i) { const float gv = acc[ai][0][m][n][i] * rs, uv = acc[ai][1][m][n][i] * rs; o[n * 4 + i] = gv * sigmoidf_(gv) * uv; }
                *(u32x4*)(act + (size_t)r * DFF + col0) = pack8(o);
            }
    }
};
struct EpiRes {
    static constexpr bool PERM = true;
    const bf16_t* resb; float* outf; bf16_t* hb; float* part; float coef;
    __device__ __forceinline__ void operator()(const f32x4 (&acc)[2][2][4][2], const pg8::Unit& u, int wr, int wc, int fr, int fq) const {
        const int row0 = u.pm * 256 + wr * 64 + fr, col0 = u.pn * 256 + wc * 32 + 8 * fq;
#pragma unroll
        for (int ai = 0; ai < 2; ++ai) {
            u32x4 rb[4][2];
#pragma unroll
            for (int m = 0; m < 4; ++m)
#pragma unroll
                for (int bj = 0; bj < 2; ++bj) rb[m][bj] = *(const u32x4*)(resb + (size_t)(row0 + ai * 128 + m * 16) * DM + col0 + bj * 128);
#pragma unroll
            for (int m = 0; m < 4; ++m) {
                const int r = row0 + ai * 128 + m * 16; float ss = 0.f;
#pragma unroll
                for (int bj = 0; bj < 2; ++bj) {
                    const size_t off = (size_t)r * DM + col0 + bj * 128;
                    float rv[8], o[8]; unpack8(rb[m][bj], rv);
#pragma unroll
                    for (int n = 0; n < 2; ++n)
#pragma unroll
                        for (int i = 0; i < 4; ++i) o[n * 4 + i] = rv[n * 4 + i] + coef * acc[ai][bj][m][n][i];
                    if (outf) { *(f32x4*)(outf + off) = (f32x4){o[0], o[1], o[2], o[3]}; *(f32x4*)(outf + off + 4) = (f32x4){o[4], o[5], o[6], o[7]}; }
                    if (hb) { *(u32x4*)(hb + off) = pack8(o);
#pragma unroll
                        for (int i = 0; i < 8; ++i) ss += o[i] * o[i]; }
                }
                if (hb) { ss += __shfl_xor(ss, 16); ss += __shfl_xor(ss, 32); if (fq == 0) part[(size_t)r * 32 + u.pn * 4 + wc] = ss; }
            }
        }
    }
};
struct EpiZ {
    static constexpr bool PERM = true;
    bf16_t* Z1; bf16_t* XCC; bf16_t* BB; bf16_t* G; const float* part; const float* partm; PG8_LAS float* rs_lds; mutable int cached_pm;
    __device__ __forceinline__ void operator()(const f32x4 (&acc)[2][2][4][2], const pg8::Unit& u, int wr, int wc, int fr, int fq) const {
        const int row0 = u.pm * 256 + wr * 64 + fr; const int pn = u.pn;
        bf16_t* base; int ld, cb; const bool paired = (pn >= 11 && pn < 19);
        if (pn < 11) { base = Z1; ld = LDZ; cb = pn * 256; } else if (pn < 19) { base = XCC; ld = LDX; cb = (pn - 11) * 128; } else if (pn < 23) { base = BB; ld = LDX; cb = (pn - 19) * 256; } else { base = G; ld = LDG; cb = (pn - 23) * 256; }
        cb += wc * 32 + 8 * fq;
        float rsv[8]; PG8_LAS float* mine = rs_lds + (wr * 4 + wc) * 512 + fq * 16 + fr;
        if (u.pm < 64 && u.pm == cached_pm) {
#pragma unroll
            for (int k = 0; k < 8; ++k) rsv[k] = mine[k * 64]; }
        else if (u.pm < 64) { rstd8(part, row0, fq, rsv);
#pragma unroll
            for (int k = 0; k < 8; ++k) mine[k * 64] = rsv[k];
            cached_pm = u.pm; }
        else {
#pragma unroll
            for (int k = 0; k < 8; ++k) rsv[k] = 0.f;
            const f32x4* pp = (const f32x4*)(partm + fr * 128 + fq * 32); float sm = 0.f;
#pragma unroll
            for (int i = 0; i < 8; ++i) { const f32x4 v = pp[i]; sm += (v[0] + v[1]) + (v[2] + v[3]); }
            sm += __shfl_xor(sm, 16); sm += __shfl_xor(sm, 32);
            if (wr == 0) rsv[0] = rsqrtf(sm * (1.0f / 2048.0f) + EPS);
        }
#pragma unroll
        for (int ai = 0; ai < 2; ++ai)
#pragma unroll
            for (int m = 0; m < 4; ++m) {
                const int r = row0 + ai * 128 + m * 16; const float rs = rsv[ai * 4 + m];
                bf16_t* rowp = base + (size_t)r * ld + cb;
                if (paired) {
                    float o[8]; const float rs2 = rs * rs;
#pragma unroll
                    for (int n = 0; n < 2; ++n)
#pragma unroll
                        for (int i = 0; i < 4; ++i) o[n * 4 + i] = acc[ai][0][m][n][i] * acc[ai][1][m][n][i] * rs2;
                    *(u32x4*)rowp = pack8(o);
                } else {
#pragma unroll
                    for (int bj = 0; bj < 2; ++bj) { float o[8];
#pragma unroll
                        for (int n = 0; n < 2; ++n)
#pragma unroll
                            for (int i = 0; i < 4; ++i) o[n * 4 + i] = acc[ai][bj][m][n][i] * rs;
                        *(u32x4*)(rowp + bj * 128) = pack8(o); }
                }
            }
    }
};
struct EpiGate {
    static constexpr bool PERM = true;
    bf16_t* G; int mode;
    __device__ __forceinline__ void operator()(const f32x4 (&acc)[2][2][4][2], const pg8::Unit& u, int wr, int wc, int fr, int fq) const {
        const int row0 = u.pm * 256 + wr * 64 + fr, col0 = u.pn * 256 + wc * 32 + 8 * fq;
#pragma unroll
        for (int ai = 0; ai < 2; ++ai) {
            u32x4 la[4][2], lg[4][2];
#pragma unroll
            for (int m = 0; m < 4; ++m)
#pragma unroll
                for (int bj = 0; bj < 2; ++bj) { const bf16_t* p = G + (size_t)(row0 + ai * 128 + m * 16) * LDG + col0 + bj * 128;
                    la[m][bj] = *(const u32x4*)p; if (mode != 0) lg[m][bj] = *(const u32x4*)(p + 2048); else lg[m][bj] = la[m][bj]; }
#pragma unroll
            for (int m = 0; m < 4; ++m)
#pragma unroll
                for (int bj = 0; bj < 2; ++bj) {
                    bf16_t* p = G + (size_t)(row0 + ai * 128 + m * 16) * LDG + col0 + bj * 128;
                    float a[8], gt[8], o[8];
                    unpack8(la[m][bj], a);
                    if (mode == 0) {
#pragma unroll
                        for (int n = 0; n < 2; ++n)
#pragma unroll
                            for (int i = 0; i < 4; ++i) o[n * 4 + i] = sigmoidf_(a[n * 4 + i]) * acc[ai][bj][m][n][i];
                    } else {
                        unpack8(lg[m][bj], gt);
#pragma unroll
                        for (int n = 0; n < 2; ++n)
#pragma unroll
                            for (int i = 0; i < 4; ++i) o[n * 4 + i] = a[n * 4 + i] + sigmoidf_(gt[n * 4 + i]) * acc[ai][bj][m][n][i];
                    }
                    *(u32x4*)p = pack8(o);
                }
        }
    }
};

template <bool PAIR, int STEPS, class F>
__device__ __forceinline__ void skinny16(const bf16_t* A, int lda, const bf16_t* Bt, int K, int ntasks, unsigned char* lds, F&& epi) {
    const int lane = threadIdx.x & 63, wv_ = threadIdx.x >> 6, r = lane & 15, kq = lane >> 4;
    f32x4* red = (f32x4*)lds;
    for (int task = blockIdx.x; task < ntasks; task += gridDim.x) {
        int n0, n1;
        if (PAIR) { n0 = (task >> 3) * 256 + (task & 7) * 16; n1 = n0 + 128; } else { n0 = task * 16; n1 = n0; }
        const int kbeg = wv_ * STEPS * 32;
        const bf16_t* ap = A + (size_t)r * lda + kbeg + kq * 8;
        const bf16_t* b0 = Bt + (size_t)(n0 + r) * K + kbeg + kq * 8;
        const bf16_t* b1 = Bt + (size_t)(n1 + r) * K + kbeg + kq * 8;
        f32x4 acc0 = {0.f, 0.f, 0.f, 0.f}, acc1 = {0.f, 0.f, 0.f, 0.f};
#pragma unroll
        for (int st = 0; st < STEPS; ++st) {
            const bf16x8 a = *(const bf16x8*)(ap + st * 32), x0 = *(const bf16x8*)(b0 + st * 32);
            acc0 = __builtin_amdgcn_mfma_f32_16x16x32_bf16(a, x0, acc0, 0, 0, 0);
            if (PAIR) { const bf16x8 x1 = *(const bf16x8*)(b1 + st * 32); acc1 = __builtin_amdgcn_mfma_f32_16x16x32_bf16(a, x1, acc1, 0, 0, 0); }
        }
        red[(wv_ * 2 + 0) * 64 + lane] = acc0; if (PAIR) red[(wv_ * 2 + 1) * 64 + lane] = acc1;
        __syncthreads();
        if (wv_ == 0) {
            f32x4 s0 = red[lane], s1 = {0.f, 0.f, 0.f, 0.f}; if (PAIR) s1 = red[64 + lane];
#pragma unroll
            for (int w = 1; w < 8; ++w) { s0 += red[(w * 2) * 64 + lane]; if (PAIR) s1 += red[(w * 2 + 1) * 64 + lane]; }
            epi(s0, s1, task, n0, r, kq);
        }
        __syncthreads();
    }
}

struct ConvJob { const float* W0; const float* W1; const float* g; bf16_t* dst; int ldw, K, N, mode; };
__device__ __forceinline__ void convert_unit(const ConvJob& J, int u, int lane) {
    const int nkb = J.K / 32;
    {
        const int ch = u / nkb, kb = u % nkb;
        const int n = ch * 256 + lane * 4; const float* src = J.W0; int col = n;
        if (J.mode == 1) { col = (n >> 8) * 128 + (n & 127); if ((n >> 7) & 1) src = J.W1; }
        else if (J.mode == 2) { const int pn = n >> 8;
            if (pn < 11) col = (n < 2640) ? n : -1;
            else if (pn < 19) col = (((n >> 7) & 1) ? 4688 : 2640) + (pn - 11) * 128 + (n & 127);
            else if (pn < 23) col = 3664 + (n - 19 * 256);
            else col = 5712 + (n - 23 * 256); }
        const float* sp = src + (size_t)(kb * 32) * J.ldw + (col >= 0 ? col : 0);
        f32x4 v[4][8];
#pragma unroll
        for (int it = 0; it < 4; ++it)
#pragma unroll
            for (int i = 0; i < 8; ++i) v[it][i] = __builtin_nontemporal_load((const f32x4*)(sp + (size_t)(it * 8 + i) * J.ldw));
        if (col < 0) {
#pragma unroll
            for (int it = 0; it < 4; ++it)
#pragma unroll
                for (int i = 0; i < 8; ++i) v[it][i] = (f32x4){0.f, 0.f, 0.f, 0.f}; }
        if (J.g) {
#pragma unroll
            for (int it = 0; it < 4; ++it)
#pragma unroll
                for (int i = 0; i < 8; ++i) v[it][i] *= J.g[kb * 32 + it * 8 + i]; }
        bf16_t* dp = J.dst + (size_t)n * J.K + kb * 32;
#pragma unroll
        for (int jn = 0; jn < 4; ++jn)
#pragma unroll
            for (int it = 0; it < 4; ++it) { u32x4 w; w.x = cvt_pk_bf16(v[it][0][jn], v[it][1][jn]); w.y = cvt_pk_bf16(v[it][2][jn], v[it][3][jn]); w.z = cvt_pk_bf16(v[it][4][jn], v[it][5][jn]); w.w = cvt_pk_bf16(v[it][6][jn], v[it][7][jn]);
                *(u32x4*)(dp + (size_t)jn * J.K + it * 8) = w; }
    }
}

struct Params {
    const float* x; const float* meta; const float* g1; const float* wg1; const float* wu1; const float* wd1;
    const float* gm; const float* win; const float* qg; const float* kg; const float* cw; const float* cbias;
    const float* wa; const float* wc; const float* wo; const float* g2; const float* wg2; const float* wu2; const float* wd2;
    float* out; unsigned char* ws;
};

__device__ __forceinline__ int key_row(int b, int t) { return t < NMETA ? MMAIN + t : b * SEQ + t - NMETA; }

__device__ __forceinline__ void sincos_d(double a, float& s_out, float& c_out) {
    const double TWO_PI = 6.283185307179586476925286766559, INV = 0.15915494309189533576888376337251;
    const double n = rint(a * INV); double r = a - n * TWO_PI;
    const double y = 0.5 * r, y2 = y * y;
    double s = 1.0, c = 1.0, ts = 1.0, tc = 1.0;
#pragma unroll
    for (int k = 1; k <= 12; ++k) { tc *= -y2 / (double)((2 * k - 1) * (2 * k)); ts *= -y2 / (double)((2 * k) * (2 * k + 1)); c += tc; s += ts; }
    s *= y;
    s_out = (float)(2.0 * s * c); c_out = (float)(1.0 - 2.0 * s * s);
}

__device__ __forceinline__ void phase_prep(const Params& P, unsigned char* lds) {
    unsigned char* ws = P.ws;
    const int tid = threadIdx.x, lane = tid & 63, wave = tid >> 6;
    { float* rope = (float*)(ws + WS_ROPE);
      for (int idx = blockIdx.x * 512 + tid; idx < TT * 24; idx += gridDim.x * 512) {
          const int t = idx / 24, f = idx % 24; float inv;
          if (f < 16) inv = (float)exp2(-((double)(2 * f) / 32.0) * 18.931568569324174);
          else inv = (float)exp2(-((double)(2 * (f - 16)) / 16.0) * 18.931568569324174);
          const float ang = (float)t * inv; float s, c; sincos_d((double)ang, s, c);
          if (f < 16) { rope[t * 48 + f] = c; rope[t * 48 + 16 + f] = s; } else { rope[t * 48 + 32 + (f - 16)] = c; rope[t * 48 + 40 + (f - 16)] = s; }
      } }
    { bf16_t* HB = (bf16_t*)(ws + WS_HB); float* part = (float*)(ws + WS_PART); float* hmeta = (float*)(ws + WS_HMETA);
      for (int r = blockIdx.x * 8 + wave; r < MPAD; r += gridDim.x * 8) {
          const float* src = r < MMAIN ? P.x + (size_t)r * DM : (r < MMAIN + NMETA ? P.meta + (size_t)(r - MMAIN) * DM : nullptr);
          float ss = 0.f;
#pragma unroll
          for (int i = 0; i < 8; ++i) { const int c = i * 256 + lane * 4; f32x4 v = src ? __builtin_nontemporal_load((const f32x4*)(src + c)) : (f32x4){0.f, 0.f, 0.f, 0.f};
              ss += (v[0] * v[0] + v[1] * v[1]) + (v[2] * v[2] + v[3] * v[3]);
              u32x2 w; w.x = cvt_pk_bf16(v[0], v[1]); w.y = cvt_pk_bf16(v[2], v[3]); *(u32x2*)(HB + (size_t)r * DM + c) = w;
              if (r >= MMAIN) *(f32x4*)(hmeta + (size_t)(r - MMAIN) * DM + c) = v; }
#pragma unroll
          for (int o = 32; o >= 1; o >>= 1) ss += __shfl_xor(ss, o);
          if (lane < 32) part[(size_t)r * 32 + lane] = (lane == 0) ? ss : 0.f;
      } }
    {
        unsigned char* w = ws;
        const int lane_ = tid & 63, gw = blockIdx.x * 8 + wave, nw = gridDim.x * 8;
        constexpr int U0 = 44 * 64, U1 = U0 + 8 * 176, U2 = U1 + 44 * 64, U3 = U2 + 8 * 176, U4 = U3 + 39 * 64, U5 = U4 + 8 * 32, U6 = U5 + 8 * 32, U7 = U6 + 8 * 64;
        for (int u = gw; u < U7; u += nw) {
            if (u < U0)      { ConvJob J{P.wg1, P.wu1, P.g1, (bf16_t*)(w + WS_WGU), DFF, DM, 11264, 1}; convert_unit(J, u, lane_); }
            else if (u < U1) { ConvJob J{P.wd1, nullptr, nullptr, (bf16_t*)(w + WS_WD), DM, DFF, 2048, 0}; convert_unit(J, u - U0, lane_); }
            else if (u < U2) { ConvJob J{P.wg2, P.wu2, P.g2, (bf16_t*)(w + WS_WGU2), DFF, DM, 11264, 1}; convert_unit(J, u - U1, lane_); }
            else if (u < U3) { ConvJob J{P.wd2, nullptr, nullptr, (bf16_t*)(w + WS_WD2), DM, DFF, 2048, 0}; convert_unit(J, u - U2, lane_); }
            else if (u < U4) { ConvJob J{P.win, nullptr, P.gm, (bf16_t*)(w + WS_WIN), 9808, DM, NIN, 2}; convert_unit(J, u - U3, lane_); }
            else if (u < U5) { ConvJob J{P.wa, nullptr, nullptr, (bf16_t*)(w + WS_WA), DM, 1024, 2048, 0}; convert_unit(J, u - U4, lane_); }
            else if (u < U6) { ConvJob J{P.wc, nullptr, nullptr, (bf16_t*)(w + WS_WC), DM, 1024, 2048, 0}; convert_unit(J, u - U5, lane_); }
            else             { ConvJob J{P.wo, nullptr, nullptr, (bf16_t*)(w + WS_WO), DM, DM, 2048, 0}; convert_unit(J, u - U6, lane_); }
        }
    }
}

__device__ __forceinline__ void norm_rope16(u32x4& w0, u32x4& w1, const f32x4 (&gn)[4], const f32x4 (&cs)[8], int part) {
    float v[16];
    { float a[8], b[8]; unpack8(w0, a); unpack8(w1, b);
#pragma unroll
      for (int i = 0; i < 8; ++i) { v[i] = a[i]; v[8 + i] = b[i]; } }
    float ss = 0.f;
#pragma unroll
    for (int i = 0; i < 16; ++i) ss += v[i] * v[i];
    ss += __shfl_xor(ss, 1); ss += __shfl_xor(ss, 2); ss += __shfl_xor(ss, 4);
    const float rs = rsqrtf(ss * (1.0f / 128.0f) + EPS);
    float y[16];
#pragma unroll
    for (int i = 0; i < 16; ++i) y[i] = v[i] * rs * gn[i >> 2][i & 3];
#pragma unroll
    for (int i = 0; i < 16; ++i) { const float other = __shfl_xor(y[i], 1);
        if (part < 2) { const float c = cs[i >> 2][i & 3], sn = cs[4 + (i >> 2)][i & 3];
            y[i] = (part == 0) ? (y[i] * c - other * sn) : (y[i] * c + other * sn); } }
    { float a[8], b[8];
#pragma unroll
      for (int i = 0; i < 8; ++i) { a[i] = y[i]; b[i] = y[8 + i]; }
      w0 = pack8(a); w1 = pack8(b); }
}
__device__ __forceinline__ void rope_idx16(u32x4& w0, u32x4& w1, const f32x4 (&ci)[4]  ) {
    float a[8], b[8]; unpack8(w0, a); unpack8(w1, b);
    float r1[8], r2[8];
#pragma unroll
    for (int i = 0; i < 8; ++i) { const float c = ci[i >> 2][i & 3], sn = ci[2 + (i >> 2)][i & 3]; r1[i] = a[i] * c - b[i] * sn; r2[i] = b[i] * c + a[i] * sn; }
    w0 = pack8(r1); w1 = pack8(r2);
}
__device__ __forceinline__ void phase_post(const Params& P, unsigned char* lds) {
    unsigned char* ws = P.ws;
    bf16_t* Z1 = (bf16_t*)(ws + WS_Z1); bf16_t* XCC = (bf16_t*)(ws + WS_XCC); bf16_t* BB = (bf16_t*)(ws + WS_BB); bf16_t* HB = (bf16_t*)(ws + WS_HB);
    bf16_t* VT = (bf16_t*)(ws + WS_VT); const float* rope = (const float*)(ws + WS_ROPE);
    const int tid = threadIdx.x, lane = tid & 63, wave = tid >> 6;
    bf16_t* vt_l = (bf16_t*)lds;
    float* tq = (float*)(lds + 16384); float* tk = tq + 128; float* tcw = tk + 128; float* tcb = tcw + 3072;
    for (int i = tid; i < 128 + 128 + 3072 + 1024; i += 512) tq[i] = i < 128 ? P.qg[i] : (i < 256 ? P.kg[i - 128] : (i < 3328 ? P.cw[i - 256] : P.cbias[i - 3328]));
    __syncthreads();
    for (int blk = blockIdx.x; blk < 513; blk += gridDim.x) {
        const bool mblk = (blk == 512);
        const int b = blk >> 6, j = blk & 63;
        const int nrows = mblk ? 16 : 32, rbase = mblk ? MMAIN : b * SEQ + j * 32, t0 = mblk ? 0 : j * 32 + NMETA;
        for (int rl = wave; rl < nrows; rl += 8) {
            const int r = rbase + rl, t = t0 + rl; const float* rt = rope + (size_t)t * 48;
            bf16_t* zr = Z1 + (size_t)r * LDZ;
            bf16_t* qp = zr + 16 * lane; bf16_t* kp = zr + 1024 + 16 * (lane & 15); bf16_t* ip = zr + 1536 + 16 * lane; bf16_t* jp = zr + 2560 + 16 * (lane & 3);
            u32x4 q0 = *(const u32x4*)qp, q1 = *(const u32x4*)(qp + 8), k0 = *(const u32x4*)kp, k1 = *(const u32x4*)(kp + 8);
            u32x4 i0 = *(const u32x4*)ip, i1 = *(const u32x4*)(ip + 8), j0 = *(const u32x4*)jp, j1 = *(const u32x4*)(jp + 8);
            const u32x4 vv = *(const u32x4*)(zr + 1280 + (lane & 31) * 8);
            f32x4 cs[8], ci[4];
#pragma unroll
            for (int i = 0; i < 8; ++i) cs[i] = *(const f32x4*)(rt + 4 * i);
#pragma unroll
            for (int i = 0; i < 4; ++i) ci[i] = *(const f32x4*)(rt + 32 + 4 * i);
            if (!mblk) {
                const int c = lane * 16;
                const int sidx = r & (SEQ - 1);
                const int r1 = sidx >= 1 ? r - 1 : MMAIN + 15, r2 = sidx >= 2 ? r - 2 : MMAIN + 14 + sidx;
                u32x4 x0[2], x1[2], x2[2], bv[2]; f32x4 cw0[4], cw1[4], cw2[4], cb[4];
#pragma unroll
                for (int hq = 0; hq < 2; ++hq) { x0[hq] = *(const u32x4*)(XCC + (size_t)r * LDX + c + hq * 8); x1[hq] = *(const u32x4*)(XCC + (size_t)r1 * LDX + c + hq * 8);
                    x2[hq] = *(const u32x4*)(XCC + (size_t)r2 * LDX + c + hq * 8); bv[hq] = *(const u32x4*)(BB + (size_t)r * LDX + c + hq * 8); }
#pragma unroll
                for (int i = 0; i < 4; ++i) { cw0[i] = *(const f32x4*)(tcw + c + 4 * i); cw1[i] = *(const f32x4*)(tcw + 1024 + c + 4 * i); cw2[i] = *(const f32x4*)(tcw + 2048 + c + 4 * i); cb[i] = *(const f32x4*)(tcb + c + 4 * i); }
#pragma unroll
                for (int hq = 0; hq < 2; ++hq) { float a0[8], a1[8], a2[8], ab[8], o[8];
                    unpack8(x0[hq], a0); unpack8(x1[hq], a1); unpack8(x2[hq], a2); unpack8(bv[hq], ab);
#pragma unroll
                    for (int i = 0; i < 8; ++i) { const int q4 = hq * 2 + (i >> 2), e = i & 3;
                        const float y = cw0[q4][e] * a2[i] + cw1[q4][e] * a1[i] + cw2[q4][e] * a0[i] + cb[q4][e]; o[i] = ab[i] * y; }
                    *(u32x4*)(BB + (size_t)r * LDX + c + hq * 8) = pack8(o); }
            }
            f32x4 gq[4], gk[4];
#pragma unroll
            for (int i = 0; i < 4; ++i) { gq[i] = *(const f32x4*)(tq + (lane & 7) * 16 + 4 * i); gk[i] = *(const f32x4*)(tk + (lane & 7) * 16 + 4 * i); }
            norm_rope16(q0, q1, gq, cs, lane & 7);
            norm_rope16(k0, k1, gk, cs, lane & 7);
            rope_idx16(i0, i1, ci);
            const u32x4 j0raw = j0, j1raw = j1;
            rope_idx16(j0, j1, ci);
            *(u32x4*)qp = q0; *(u32x4*)(qp + 8) = q1;
            if (lane < 16) { *(u32x4*)kp = k0; *(u32x4*)(kp + 8) = k1; }
            if ((lane & 3) == 0) { *(u32x4*)ip = i0; *(u32x4*)(ip + 8) = i1; }
            if (lane == 0) { *(u32x4*)jp = j0; *(u32x4*)(jp + 8) = j1; }
            if (lane < 4) {
                const int half = lane >> 1, kk0 = 2 * (lane & 1);
                const int bb0 = mblk ? 0 : b, bb1 = mblk ? NBATCH : b + 1;
                for (int bb = bb0; bb < bb1; ++bb) {
                    unsigned char* kt = ws + WS_KI2 + ((size_t)bb * 65 + (t >> 5)) * 4096 + (half * 32 + (t & 31)) * 16;
                    *(u32x4*)(kt + kk0 * 1024) = (lane == 0) ? j0 : j0raw; *(u32x4*)(kt + (kk0 + 1) * 1024) = (lane == 0) ? j1 : j1raw; }
            }
            if (lane < 32) *(u32x4*)(vt_l + rl * 256 + lane * 8) = vv;
        }
        __syncthreads();
        { const int gd = tid >> 1, half = tid & 1;
          if (half * 16 < nrows) {
              unsigned w[8];
#pragma unroll
              for (int pp = 0; pp < 8; ++pp) { unsigned lo, hi;
                  { const int p0 = 2 * pp, kk = 8 * ((p0 >> 2) & 1) + 4 * (p0 >> 3) + (p0 & 3); lo = vt_l[(half * 16 + kk) * 256 + gd]; }
                  { const int p1 = 2 * pp + 1, kk = 8 * ((p1 >> 2) & 1) + 4 * (p1 >> 3) + (p1 & 3); hi = vt_l[(half * 16 + kk) * 256 + gd]; }
                  w[pp] = lo | (hi << 16); }
              u32x4 w0 = {w[0], w[1], w[2], w[3]}, w1 = {w[4], w[5], w[6], w[7]};
              const int bb0 = mblk ? 0 : b, bb1 = mblk ? NBATCH : b + 1;
              const int tpos = t0 + half * 16;
              for (int bb = bb0; bb < bb1; ++bb) { bf16_t* d = VT + (((size_t)bb * 65 + (tpos >> 5)) * 256 + gd) * 32 + (tpos & 31); *(u32x4*)d = w0; *(u32x4*)(d + 8) = w1; }
          }
          if (!mblk && j == 63 && half == 0) { bf16_t* d = VT + (((size_t)b * 65 + 64) * 256 + gd) * 32 + 16; u32x4 z = {0u, 0u, 0u, 0u}; *(u32x4*)d = z; *(u32x4*)(d + 8) = z; }
        }
        __syncthreads();
    }
}

__device__ __forceinline__ unsigned ordered_key(float f) { const unsigned u = __float_as_uint(f); return u ^ ((u >> 31) ? 0xffffffffu : 0x80000000u); }
constexpr int ATT_SC_OFF = 0, ATT_BM_OFF = 133120, ATT_K_OFF = 0, ATT_V_OFF = 32768;
__device__ __forceinline__ void phase_attn(const Params& P, unsigned char* lds) {
    unsigned char* ws = P.ws;
    const bf16_t* Z1 = (const bf16_t*)(ws + WS_Z1); const bf16_t* VT = (const bf16_t*)(ws + WS_VT); bf16_t* AO = (bf16_t*)(ws + WS_XCC);
    const int tid = threadIdx.x, lane = tid & 63, wave = tid >> 6, lr = lane & 31, hh = lane >> 5;
    unsigned* scU = (unsigned*)(lds + ATT_SC_OFF); unsigned* bm = (unsigned*)(lds + ATT_BM_OFF);
    for (int idx = blockIdx.x; idx < 512; idx += gridDim.x) {
        const int b = idx & 7; const int j = idx < 256 ? 63 - (idx >> 3) : ((idx - 256) >> 3);
        const int s0 = j * 32, ntiles = j + 2;
        for (int pp = 0; pp < 2; ++pp) {
            const int p = wave * 2 + pp; const int sq = s0 + 2 * p + hh; const int rowq = b * SEQ + sq;
            bf16x8 Aq[4];
            { const int qa = s0 + 2 * p + ((lr >> 2) & 1), ha = (lr & 3) + 4 * (lr >> 3);
              const bf16_t* ap = Z1 + (size_t)(b * SEQ + qa) * LDZ + 1536 + ha * 64 + hh * 32;
#pragma unroll
              for (int kk = 0; kk < 4; ++kk) Aq[kk] = *(const bf16x8*)(ap + kk * 8); }
            float wv[16];
            { float a[8], c[8]; unpack8(*(const u32x4*)(Z1 + (size_t)rowq * LDZ + 2624), a); unpack8(*(const u32x4*)(Z1 + (size_t)rowq * LDZ + 2632), c);
#pragma unroll
              for (int i = 0; i < 8; ++i) { wv[i] = a[i]; wv[8 + i] = c[i]; } }
            unsigned* myrow = scU + (wave * 2 + hh) * TPAD + lr;
            bf16x8 B0[4], B1[4], B2[4], B3[4];
#define IDX_LOAD(BUF, tl) do { const int tc_ = (tl) < 64 ? (tl) : 64; const unsigned char* bp_ = ws + WS_KI2 + ((size_t)b * 65 + tc_) * 4096 + (hh * 32 + lr) * 16; \
                _Pragma("unroll") for (int kk = 0; kk < 4; ++kk) BUF[kk] = *(const bf16x8*)(bp_ + kk * 1024); } while (0)
#define IDX_TILE(BUF, tl) do { const int t_ = (tl) * 32 + lr; f32x16 acc_; \
                _Pragma("unroll") for (int i = 0; i < 16; ++i) acc_[i] = 0.f; \
                _Pragma("unroll") for (int kk = 0; kk < 4; ++kk) acc_ = __builtin_amdgcn_mfma_f32_32x32x16_bf16(Aq[kk], BUF[kk], acc_, 0, 0, 0); \
                IDX_LOAD(BUF, (tl) + 4); \
                float sc_ = 0.f, sd_ = 0.f; \
                _Pragma("unroll") for (int i = 0; i < 16; i += 2) { sc_ += wv[i] * __int_as_float(max(__float_as_int(acc_[i]), 0)); sd_ += wv[i + 1] * __int_as_float(max(__float_as_int(acc_[i + 1]), 0)); } \
                sc_ += sd_; \
                myrow[(tl) * 32] = (t_ <= sq + NMETA) ? ordered_key(sc_) : 0u; } while (0)
            IDX_LOAD(B0, 0); IDX_LOAD(B1, 1); IDX_LOAD(B2, 2); IDX_LOAD(B3, 3);
            for (int tile = 0; tile < ntiles; tile += 4) {
                IDX_TILE(B0, tile);
                if (tile + 1 < ntiles) IDX_TILE(B1, tile + 1);
                if (tile + 2 < ntiles) IDX_TILE(B2, tile + 2);
                if (tile + 3 < ntiles) IDX_TILE(B3, tile + 3);
            }
#undef IDX_LOAD
#undef IDX_TILE
            const int nch = (ntiles + 7) >> 3;
            for (int tile = ntiles; tile < nch * 8 && tile < 65; ++tile) myrow[tile * 32] = 0u;
            unsigned key[72];
#pragma unroll
            for (int ch = 0; ch < 9; ++ch) {
                if (ch < nch) {
#pragma unroll
                    for (int jj = 0; jj < 8; ++jj) { const int jx = ch * 8 + jj; key[jx] = (jx < 65) ? myrow[jx * 32] : 0u; }
                } else {
#pragma unroll
                    for (int jj = 0; jj < 8; ++jj) key[ch * 8 + jj] = 0u;
                }
            }
            unsigned prefix = 0u;
            for (int bit = 31; bit >= 8; --bit) {
                const unsigned cand = prefix | (1u << bit); const int c31 = (int)(cand >> 1);
                int lt0 = 0, lt1 = 0;
#pragma unroll
                for (int ch = 0; ch < 9; ++ch) {
                    if (ch < nch) {
#pragma unroll
                        for (int jj = 0; jj < 8; jj += 2) { lt0 += (int)((unsigned)((int)(key[ch * 8 + jj] >> 1) - c31) >> 31); lt1 += (int)((unsigned)((int)(key[ch * 8 + jj + 1] >> 1) - c31) >> 31); }
                    }
                }
                int cnt = nch * 8 - (lt0 + lt1);
                cnt += __builtin_amdgcn_update_dpp(0, cnt, 0xB1, 0xF, 0xF, true);
                cnt += __builtin_amdgcn_update_dpp(0, cnt, 0x4E, 0xF, 0xF, true);
                cnt += __builtin_amdgcn_update_dpp(0, cnt, 0x141, 0xF, 0xF, true);
                cnt += __builtin_amdgcn_update_dpp(0, cnt, 0x140, 0xF, 0xF, true);
                cnt += __shfl_xor(cnt, 16);
                if (cnt >= 256) prefix = cand;
            }
            const unsigned thr = prefix > 1u ? prefix : 1u;
#pragma unroll
            for (int ch = 0; ch < 9; ++ch) {
                if (ch < nch) {
#pragma unroll
                    for (int jj = 0; jj < 8; ++jj) { const int jx = ch * 8 + jj;
                        if (jx < 65) { const unsigned long long bal = __ballot(key[jx] >= thr);
                            const unsigned word = hh ? (unsigned)(bal >> 32) : (unsigned)bal;
                            if (lr == 0) bm[(2 * p + hh) * 65 + jx] = word; } }
                }
            }
        }
        __syncthreads();
        {
            const int g = wave >> 2;
            bf16x8 Qf[8];
            { const bf16_t* qp = Z1 + (size_t)(b * SEQ + s0 + lr) * LDZ + wave * 128 + hh * 8;
#pragma unroll
              for (int kk = 0; kk < 8; ++kk) Qf[kk] = *(const bf16x8*)(qp + kk * 16); }
#pragma unroll
            for (int kk = 0; kk < 8; ++kk) asm volatile("" :: "v"(Qf[kk]));
            f32x16 o[4];
#pragma unroll
            for (int d = 0; d < 4; ++d)
#pragma unroll
                for (int i = 0; i < 16; ++i) o[d][i] = 0.f;
            float m = -1e30f, l = 0.f;
            const int kkey0 = tid >> 5, kch = tid & 31;
            const int vrow0 = tid >> 2, vc4 = tid & 3;
            u32x4 sKa[2], sVa[2], sKb[2], sVb[2];
#define ATT_LOAD(SK, SV, tile_) do { _Pragma("unroll") for (int i_ = 0; i_ < 2; ++i_) { const int key_ = kkey0 + 16 * i_; int t_ = (tile_) * 32 + key_; t_ = t_ < TT ? t_ : TT - 1; \
                SK[i_] = *(const u32x4*)(Z1 + (size_t)key_row(b, t_) * LDZ + 1024 + kch * 8); \
                SV[i_] = *(const u32x4*)(VT + (((size_t)b * 65 + (tile_)) * 256 + vrow0 + 128 * i_) * 32 + vc4 * 8); } } while (0)
#define ATT_STORE(SK, SV, buf_) do { _Pragma("unroll") for (int i_ = 0; i_ < 2; ++i_) { const int key_ = kkey0 + 16 * i_; \
                *(u32x4*)(lds + ATT_K_OFF + (buf_) * 16384 + key_ * 512 + (kch >> 4) * 256 + (((kch & 15) ^ (key_ & 15)) * 16)) = SK[i_]; \
                *(u32x4*)(lds + ATT_V_OFF + (buf_) * 20480 + (vrow0 + 128 * i_) * 80 + vc4 * 16) = SV[i_]; } } while (0)
            auto tile_body = [&](const int tile, const int buf) __attribute__((always_inline)) {
                f32x16 S;
#pragma unroll
                for (int i = 0; i < 16; ++i) S[i] = 0.f;
                const unsigned char* kb = lds + ATT_K_OFF + buf * 16384 + lr * 512 + g * 256;
#pragma unroll
                for (int kk = 0; kk < 8; ++kk) { const bf16x8 Kf = *(const bf16x8*)(kb + (((2 * kk + hh) ^ (lr & 15)) * 16)); S = __builtin_amdgcn_mfma_f32_32x32x16_bf16(Kf, Qf[kk], S, 0, 0, 0); }
                const unsigned bits2 = bm[lr * 65 + tile] >> (4 * hh);
                float mx = S[0];
#pragma unroll
                for (int i = 1; i < 16; ++i) mx = __builtin_fmaxf(mx, S[i]);
                mx *= 0.12751743f;
                mx = __builtin_fmaxf(mx, __shfl_xor(mx, 32));
                if (__any(mx > m)) { const float mn = __builtin_fmaxf(m, mx), al = __builtin_amdgcn_exp2f(m - mn);
#pragma unroll
                    for (int d = 0; d < 4; ++d)
#pragma unroll
                        for (int i = 0; i < 16; ++i) o[d][i] *= al;
                    l *= al; m = mn; }
                float pr[16];
#pragma unroll
                for (int i = 0; i < 16; ++i) { const int mk = __builtin_amdgcn_sbfe((int)bits2, (i & 3) + 8 * (i >> 2), 1);
                    const float e = __builtin_amdgcn_exp2f(__builtin_fmaf(S[i], 0.12751743f, -m));
                    pr[i] = __int_as_float(__float_as_int(e) & mk); l += pr[i]; }
                bf16x8 Pf[2];
#pragma unroll
                for (int s2 = 0; s2 < 2; ++s2) { u32x4 w; w.x = cvt_pk_bf16(pr[8 * s2 + 0], pr[8 * s2 + 1]); w.y = cvt_pk_bf16(pr[8 * s2 + 2], pr[8 * s2 + 3]);
                    w.z = cvt_pk_bf16(pr[8 * s2 + 4], pr[8 * s2 + 5]); w.w = cvt_pk_bf16(pr[8 * s2 + 6], pr[8 * s2 + 7]); Pf[s2] = __builtin_bit_cast(bf16x8, w); }
                const unsigned char* vb = lds + ATT_V_OFF + buf * 20480 + (g * 128 + lr) * 80 + hh * 16;
#pragma unroll
                for (int d = 0; d < 4; ++d)
#pragma unroll
                    for (int s2 = 0; s2 < 2; ++s2) { const bf16x8 Vf = *(const bf16x8*)(vb + d * 32 * 80 + s2 * 32); o[d] = __builtin_amdgcn_mfma_f32_32x32x16_bf16(Vf, Pf[s2], o[d], 0, 0, 0); }
            };
            ATT_LOAD(sKa, sVa, 0); ATT_STORE(sKa, sVa, 0);
            if (1 < ntiles) ATT_LOAD(sKb, sVb, 1);
            __syncthreads();
            for (int tile = 0; tile < ntiles; tile += 2) {
                if (tile + 2 < ntiles) ATT_LOAD(sKa, sVa, tile + 2);
                tile_body(tile, 0);
                if (tile + 1 < ntiles) ATT_STORE(sKb, sVb, 1);
                __syncthreads();
                if (tile + 1 >= ntiles) break;
                if (tile + 3 < ntiles) ATT_LOAD(sKb, sVb, tile + 3);
                tile_body(tile + 1, 1);
                if (tile + 2 < ntiles) ATT_STORE(sKa, sVa, 0);
                __syncthreads();
            }
#undef ATT_LOAD
#undef ATT_STORE
            l += __shfl_xor(l, 32);
            const float inv = 1.0f / l;
            bf16_t* op = AO + (size_t)(b * SEQ + s0 + lr) * LDX + wave * 128 + 4 * hh;
#pragma unroll
            for (int d = 0; d < 4; ++d)
#pragma unroll
                for (int q4 = 0; q4 < 4; ++q4) { u32x2 w; w.x = cvt_pk_bf16(o[d][4 * q4 + 0] * inv, o[d][4 * q4 + 1] * inv); w.y = cvt_pk_bf16(o[d][4 * q4 + 2] * inv, o[d][4 * q4 + 3] * inv);
                    *(u32x2*)(op + 32 * d + 8 * q4) = w; }
        }
        __syncthreads();
    }
}

#define XB_TMO      128
#define XB_XCNT(j)  (256  + 64 * (j))
#define XB_XSUB(j)  (1280 + 64 * (j))
#define XB_XGEN(j)  (2304 + 64 * (j))
#define XB_TOP      3328
#define XB_TOPGEN   3392
#define XCD_BAR_WORDS 3456
#define XB_SPIN_CAP (1u << 18)
__device__ __forceinline__ unsigned xb_ld(unsigned* p)              { return __hip_atomic_load(p, __ATOMIC_RELAXED, __HIP_MEMORY_SCOPE_AGENT); }
__device__ __forceinline__ unsigned xb_add(unsigned* p, unsigned v) { return __hip_atomic_fetch_add(p, v, __ATOMIC_RELAXED, __HIP_MEMORY_SCOPE_AGENT); }
__device__ __forceinline__ unsigned xb_xcc_id() { return (unsigned)__builtin_amdgcn_s_getreg((3 << 11) | 20) & 0xFu; }
#define XB_SPIN(cond, bar) do { unsigned _sp = 0; while (cond) { __builtin_amdgcn_s_sleep(1); \
    if ((++_sp & 255u) == 0u) { if (xb_ld(&(bar)[XB_TMO])) break; if (_sp > XB_SPIN_CAP) { atomicAdd(&(bar)[XB_TMO], 1u); break; } } } } while (0)
struct XcdBarrier { unsigned* bar; unsigned x; volatile PG8_LAS unsigned* st; };
__device__ __forceinline__ XcdBarrier xcd_barrier_post(unsigned* bar, volatile PG8_LAS unsigned* st) {
    XcdBarrier b; b.bar = bar; b.x = xb_xcc_id(); b.st = st;
    if (threadIdx.x == 0) (void)xb_add(&bar[XB_XCNT(b.x)], 1u);
    return b;
}
__device__ __forceinline__ void xcd_barrier_complete(unsigned* bar, unsigned x, unsigned& nloc, unsigned& nx) {
    const unsigned G = gridDim.x * gridDim.y * gridDim.z;
    unsigned sum, cnt, mine, sp = 0u;
    for (;;) {
        sum = 0u; cnt = 0u; mine = 0u;
#pragma unroll
        for (unsigned j = 0; j < 16; ++j) { const unsigned c = xb_ld(&bar[XB_XCNT(j)]); sum += c; cnt += (c > 0u) ? 1u : 0u; mine = (j == x) ? c : mine; }
        if (sum == G) break;
        __builtin_amdgcn_s_sleep(1);
        if ((++sp & 255u) == 0u) { if (xb_ld(&bar[XB_TMO])) break; if (sp > XB_SPIN_CAP) { atomicAdd(&bar[XB_TMO], 1u); break; } }
    }
    nloc = mine > 0u ? mine : 1u; nx = cnt > 0u ? cnt : 1u;
}
__device__ __forceinline__ void xcd_barrier(const XcdBarrier& b) {
    asm volatile("s_waitcnt vmcnt(0)" ::: "memory");
    __syncthreads();
    if (threadIdx.x == 0) {
        unsigned* bar = b.bar;
        __builtin_amdgcn_s_waitcnt(0);
        unsigned nloc = b.st[0], nx = b.st[1];
        if (nloc == 0u) { xcd_barrier_complete(bar, b.x, nloc, nx); b.st[0] = nloc; b.st[1] = nx; }
        const unsigned old = xb_add(&bar[XB_XSUB(b.x)], 1u);
        const unsigned gen = old / nloc;
        if (old + 1u == (gen + 1u) * nloc) {
            __builtin_amdgcn_fence(__ATOMIC_RELEASE, "agent");
            asm volatile("s_waitcnt vmcnt(0)" ::: "memory");
            const unsigned og = xb_add(&bar[XB_TOP], 1u);
            const unsigned tg = og / nx;
            if (og + 1u == (tg + 1u) * nx) xb_add(&bar[XB_TOPGEN], 1u);
            else XB_SPIN(xb_ld(&bar[XB_TOPGEN]) == tg, bar);
            __builtin_amdgcn_fence(__ATOMIC_ACQUIRE, "agent");
            xb_add(&bar[XB_XGEN(b.x)], 1u);
            asm volatile("s_waitcnt vmcnt(0)" ::: "memory");
        } else {
            XB_SPIN(xb_ld(&bar[XB_XGEN(b.x)]) == gen, bar);
            __builtin_amdgcn_fence(__ATOMIC_ACQUIRE, "agent");
            asm volatile("s_waitcnt vmcnt(0)" ::: "memory");
        }
    }
    __syncthreads();
}
__global__ void __launch_bounds__(512, 2) fwd_megakernel(Params P, int ph_lo, int ph_hi) {
    extern __shared__ __attribute__((aligned(16))) unsigned char lds[];
    cg::grid_group grid = cg::this_grid();
    unsigned char* ws = P.ws;
    PG8_LAS unsigned char* lds3 = (PG8_LAS unsigned char*)lds;
    const int G = gridDim.x, c = blockIdx.x;
    bf16_t* WGU2 = (bf16_t*)(ws + WS_WGU2); bf16_t* WD2 = (bf16_t*)(ws + WS_WD2);
    bf16_t* WGU = (bf16_t*)(ws + WS_WGU); bf16_t* WD = (bf16_t*)(ws + WS_WD); bf16_t* WIN = (bf16_t*)(ws + WS_WIN);
    bf16_t* WA = (bf16_t*)(ws + WS_WA); bf16_t* WC = (bf16_t*)(ws + WS_WC); bf16_t* WO = (bf16_t*)(ws + WS_WO);
    bf16_t* HB = (bf16_t*)(ws + WS_HB); bf16_t* ACT = (bf16_t*)(ws + WS_Z1); bf16_t* Z1 = (bf16_t*)(ws + WS_Z1);
    bf16_t* XCC = (bf16_t*)(ws + WS_XCC); bf16_t* BB = (bf16_t*)(ws + WS_BB); bf16_t* GG = (bf16_t*)(ws + WS_G);
    float* part0 = (float*)(ws + WS_PART); float* part1 = (float*)(ws + WS_PART + PART_SZ); float* part2 = (float*)(ws + WS_PART + 2 * PART_SZ);
    float* hmeta = (float*)(ws + WS_HMETA);
#define IN(k) (ph_lo <= (k) && (k) < ph_hi)
    volatile PG8_LAS unsigned* bst = (volatile PG8_LAS unsigned*)(lds3 + 147456);
    if (threadIdx.x == 0) { bst[0] = 0u; bst[1] = 0u; }
    __syncthreads();
    const XcdBarrier xbar = xcd_barrier_post((unsigned*)(ws + WS_BAR), bst);
    if (ph_hi < 0) grid.sync();
#define SEAM(k) do { if (IN(k) && IN((k) + 1)) xcd_barrier(xbar); } while (0)
    if (IN(0)) phase_prep(P, lds);
    SEAM(0);
    if (IN(1)) { pg8::Gemm g{HB, WGU, MMAIN, 11264, DM, DM, DM}; pg8::StaticOrder S; S.init(MMAIN, 11264, G, c); EpiGU E{ACT, part0, (PG8_LAS float*)(lds3 + 131072), -1}; pg8::gemm_phase(lds3, g, S, E);
        skinny16<true, 8>(HB + (size_t)MMAIN * DM, DM, WGU, DM, 44 * 8, lds, [&](const f32x4& a0, const f32x4& a1, int task, int n0, int r, int kq) {
#pragma unroll
            for (int j = 0; j < 4; ++j) { const int row = kq * 4 + j; const f32x4* pp = (const f32x4*)(part0 + (size_t)(MMAIN + row) * 32); float sm = 0.f;
#pragma unroll
                for (int i = 0; i < 8; ++i) { const f32x4 v = pp[i]; sm += (v[0] + v[1]) + (v[2] + v[3]); }
                const float rs = rsqrtf(sm * (1.0f / 2048.0f) + EPS), gv = a0[j] * rs, uv = a1[j] * rs;
                const float o = gv * sigmoidf_(gv) * uv;
                ACT[(size_t)(MMAIN + row) * DFF + (n0 >> 8) * 128 + (n0 & 127) + r] = (bf16_t)(cvt_pk_bf16(o, 0.f) & 0xffffu); }
        });
    }
    SEAM(1);
    if (IN(2)) { pg8::Gemm g{ACT, WD, MMAIN, 2048, DFF, DFF, DFF}; pg8::StaticOrder S; S.init(MMAIN, 2048, G, c);
        EpiRes E{HB, nullptr, HB, part1, 0.5f}; pg8::gemm_phase(lds3, g, S, E);
        float* partm = (float*)(ws + WS_PARTM);
        skinny16<false, 22>(ACT + (size_t)MMAIN * DFF, DFF, WD, DFF, 128, lds, [&](const f32x4& a0, const f32x4&, int task, int n0, int r, int kq) {
#pragma unroll
            for (int j = 0; j < 4; ++j) { const int row = kq * 4 + j; const float h = P.meta[(size_t)row * DM + n0 + r] + 0.5f * a0[j];
                HB[(size_t)(MMAIN + row) * DM + n0 + r] = (bf16_t)(cvt_pk_bf16(h, 0.f) & 0xffffu);
                float ss = h * h;
                ss += __int_as_float(__builtin_amdgcn_update_dpp(0, __float_as_int(ss), 0xB1, 0xF, 0xF, true));
                ss += __int_as_float(__builtin_amdgcn_update_dpp(0, __float_as_int(ss), 0x4E, 0xF, 0xF, true));
                ss += __int_as_float(__builtin_amdgcn_update_dpp(0, __float_as_int(ss), 0x141, 0xF, 0xF, true));
                ss += __int_as_float(__builtin_amdgcn_update_dpp(0, __float_as_int(ss), 0x140, 0xF, 0xF, true));
                if (r == 0) partm[row * 128 + task] = ss; }
        });
    }
    SEAM(2);
    if (IN(3)) { pg8::Gemm g{HB, WIN, MPAD, NIN, DM, DM, DM}; pg8::StaticOrder S; S.init(MPAD, NIN, G, c); EpiZ E{Z1, XCC, BB, GG, part1, (const float*)(ws + WS_PARTM), (PG8_LAS float*)(lds3 + 131072), -1}; pg8::gemm_phase(lds3, g, S, E); }
    SEAM(3);
    if (IN(4)) phase_post(P, lds);
    SEAM(4);
    if (IN(5)) phase_attn(P, lds);
    SEAM(5);
    if (IN(6)) { pg8::Gemm g{XCC, WA, MMAIN, 2048, 1024, LDX, 1024}; pg8::StaticOrder S; S.init(MMAIN, 2048, G, c); EpiGate E{GG, 0}; pg8::gemm_phase(lds3, g, S, E); }
    if (IN(7)) { pg8::Gemm g{BB, WC, MMAIN, 2048, 1024, LDX, 1024}; pg8::StaticOrder S; S.init(MMAIN, 2048, G, c); EpiGate E{GG, 1}; pg8::gemm_phase(lds3, g, S, E); }
    SEAM(7);
    if (IN(8)) { pg8::Gemm g{GG, WO, MMAIN, 2048, DM, LDG, DM}; pg8::StaticOrder S; S.init(MMAIN, 2048, G, c);
        EpiRes E{HB, nullptr, HB, part2, 1.0f}; pg8::gemm_phase(lds3, g, S, E); }
    SEAM(8);
    if (IN(9)) { pg8::Gemm g{HB, WGU2, MMAIN, 11264, DM, DM, DM}; pg8::StaticOrder S; S.init(MMAIN, 11264, G, c); EpiGU E{ACT, part2, (PG8_LAS float*)(lds3 + 131072), -1}; pg8::gemm_phase(lds3, g, S, E); }
    SEAM(9);
    if (IN(10)) { pg8::Gemm g{ACT, WD2, MMAIN, 2048, DFF, DFF, DFF}; pg8::StaticOrder S; S.init(MMAIN, 2048, G, c);
        EpiRes E{HB, P.out, nullptr, nullptr, 0.5f}; pg8::gemm_phase(lds3, g, S, E); }
#undef IN
#undef SEAM
}

extern "C" void kernel_launch(void* const* d_in, const int* in_sizes, int n_in, void* d_out, int out_size, void* d_ws, size_t ws_size, hipStream_t stream) {
    static int grid = 0;
    if (grid == 0) {
        if (n_in != 19 || ws_size < WS_END) { fprintf(stderr, "kernel_launch: unexpected n_in %d / ws_size %zu (need %zu)\n", n_in, ws_size, (size_t)WS_END); grid = -1; return; }
        int dev = 0, cus = 0, per_cu = 0;
        hipGetDevice(&dev); hipDeviceGetAttribute(&cus, hipDeviceAttributeMultiprocessorCount, dev);
        if (hipFuncSetAttribute((const void*)fwd_megakernel, hipFuncAttributeMaxDynamicSharedMemorySize, LDS_BYTES) != hipSuccess) { fprintf(stderr, "kernel_launch: hipFuncSetAttribute failed\n"); grid = -1; return; }
        if (hipOccupancyMaxActiveBlocksPerMultiprocessor(&per_cu, (const void*)fwd_megakernel, 512, LDS_BYTES) != hipSuccess || per_cu < 1) { fprintf(stderr, "kernel_launch: occupancy query says %d\n", per_cu); per_cu = 1; }
        (void)hipGetLastError();
        grid = cus;
    }
    if (grid < 0) return;
    if (hipMemsetAsync((char*)d_ws + WS_BAR, 0, 16384, stream) != hipSuccess) { fprintf(stderr, "kernel_launch: memset failed\n"); return; }
    Params p{};
    p.x = (const float*)d_in[0]; p.meta = (const float*)d_in[1]; p.g1 = (const float*)d_in[2]; p.wg1 = (const float*)d_in[3]; p.wu1 = (const float*)d_in[4]; p.wd1 = (const float*)d_in[5];
    p.gm = (const float*)d_in[6]; p.win = (const float*)d_in[7]; p.qg = (const float*)d_in[8]; p.kg = (const float*)d_in[9]; p.cw = (const float*)d_in[10]; p.cbias = (const float*)d_in[11];
    p.wa = (const float*)d_in[12]; p.wc = (const float*)d_in[13]; p.wo = (const float*)d_in[14]; p.g2 = (const float*)d_in[15]; p.wg2 = (const float*)d_in[16]; p.wu2 = (const float*)d_in[17]; p.wd2 = (const float*)d_in[18];
    p.out = (float*)d_out; p.ws = (unsigned char*)d_ws;
    int lo = 0, hi = 11;
    void* args[] = {&p, &lo, &hi};
    hipError_t e = hipLaunchCooperativeKernel((const void*)fwd_megakernel, dim3(grid), dim3(512), args, LDS_BYTES, stream);
    if (e != hipSuccess) fprintf(stderr, "cooperative launch failed: %s (grid %d)\n", hipGetErrorString(e), grid);
}
```

```cpp
#include <hip/hip_runtime.h>
#include <hip/hip_cooperative_groups.h>
#include <cstdio>
namespace cg = cooperative_groups;

typedef unsigned short bf16_t;
typedef short bf16x8 __attribute__((ext_vector_type(8)));
typedef float f32x4 __attribute__((ext_vector_type(4)));
typedef float f32x16 __attribute__((ext_vector_type(16)));
typedef unsigned u32x4 __attribute__((ext_vector_type(4)));
typedef unsigned u32x2 __attribute__((ext_vector_type(2)));

constexpr int DM = 2048, NBATCH = 8, SEQ = 2048, NMETA = 16, TT = 2064, DFF = 5632;
constexpr int MMAIN = 16384, MPAD = 16640;
constexpr int LDZ = 2816, LDX = 1024, LDG = 4096;
constexpr int NIN = 9984;
constexpr int TPAD = 2080;
constexpr float EPS = 1e-6f;
constexpr int LDS_BYTES = 147472;

constexpr size_t WS_WGU = 0;
constexpr size_t WS_WD = WS_WGU + (size_t)11264 * 2048 * 2;
constexpr size_t WS_XCC = WS_WGU;
constexpr size_t WS_BB = WS_XCC + (size_t)MPAD * LDX * 2;
constexpr size_t WS_WGU2 = WS_WD + (size_t)2048 * 5632 * 2;
constexpr size_t WS_WD2 = WS_WGU2 + (size_t)11264 * 2048 * 2;
constexpr size_t WS_WIN = WS_WD2 + (size_t)2048 * 5632 * 2;
constexpr size_t WS_WA = WS_WIN + (size_t)NIN * 2048 * 2;
constexpr size_t WS_WC = WS_WA + (size_t)2048 * 1024 * 2;
constexpr size_t WS_WO = WS_WC + (size_t)2048 * 1024 * 2;
constexpr size_t WS_HB = WS_WO + (size_t)2048 * 2048 * 2;
constexpr size_t WS_Z1 = WS_HB + (size_t)MPAD * 2048 * 2;
constexpr size_t WS_G = WS_Z1 + (size_t)MPAD * LDZ * 2;
constexpr size_t WS_VT = WS_G + (size_t)MPAD * LDG * 2;
constexpr size_t WS_PART = WS_VT + (size_t)NBATCH * 2 * 128 * TPAD * 2;
constexpr size_t PART_SZ = (size_t)MPAD * 32 * 4;
constexpr size_t WS_HMETA = WS_PART + 3 * PART_SZ;
constexpr size_t WS_ROPE = WS_HMETA + (size_t)256 * 2048 * 4;
constexpr size_t WS_PARTM = WS_ROPE + (size_t)TT * 48 * 4;
constexpr size_t WS_BAR = WS_PARTM + 16 * 128 * 4;
constexpr size_t WS_KI2 = WS_BAR + 16384;
constexpr size_t WS_END = WS_KI2 + (size_t)NBATCH * 65 * 4096;
static_assert(WS_Z1 + (size_t)MPAD * DFF * 2 <= WS_VT, "act alias");
static_assert(WS_BB + (size_t)MPAD * LDX * 2 <= WS_WGU2, "xcc/bb alias");
static_assert(WS_END <= (size_t)536870912, "workspace");

__device__ __forceinline__ unsigned cvt_pk_bf16(float lo, float hi) { unsigned r; asm volatile("v_cvt_pk_bf16_f32 %0, %1, %2" : "=v"(r) : "v"(lo), "v"(hi)); return r; }
__device__ __forceinline__ float bf_lo(unsigned w) { return __uint_as_float(w << 16); }
__device__ __forceinline__ float bf_hi(unsigned w) { return __uint_as_float(w & 0xffff0000u); }
__device__ __forceinline__ float bf2f(bf16_t b) { return __uint_as_float(((unsigned)b) << 16); }
__device__ __forceinline__ float sigmoidf_(float x) { return __builtin_amdgcn_rcpf(1.0f + __expf(-x)); }
__device__ __forceinline__ void unpack8(const u32x4 w, float (&f)[8]) {
    f[0] = bf_lo(w.x); f[1] = bf_hi(w.x); f[2] = bf_lo(w.y); f[3] = bf_hi(w.y); f[4] = bf_lo(w.z); f[5] = bf_hi(w.z); f[6] = bf_lo(w.w); f[7] = bf_hi(w.w); }
__device__ __forceinline__ u32x4 pack8(const float (&f)[8]) { u32x4 w; w.x = cvt_pk_bf16(f[0], f[1]); w.y = cvt_pk_bf16(f[2], f[3]); w.z = cvt_pk_bf16(f[4], f[5]); w.w = cvt_pk_bf16(f[6], f[7]); return w; }
__device__ __forceinline__ void rstd8(const float* part, int row0, int fq, float (&rs)[8]) {
    f32x4 v[8][2];
#pragma unroll
    for (int k = 0; k < 8; ++k) { const f32x4* p = (const f32x4*)(part + (size_t)(row0 + (k >> 2) * 128 + (k & 3) * 16) * 32 + fq * 8); v[k][0] = p[0]; v[k][1] = p[1]; }
#pragma unroll
    for (int k = 0; k < 8; ++k) { float s = ((v[k][0][0] + v[k][0][1]) + (v[k][0][2] + v[k][0][3])) + ((v[k][1][0] + v[k][1][1]) + (v[k][1][2] + v[k][1][3]));
        s += __shfl_xor(s, 16); s += __shfl_xor(s, 32); rs[k] = rsqrtf(s * (1.0f / 2048.0f) + EPS); }
}

namespace pg8 {
#define PG8_LAS __attribute__((address_space(3)))
constexpr int BM = 256, BK = 64, HALF = 128, HTB = HALF * BK * 2, STAGE_BYTES = 8 * HTB, NXCD = 8, WGM = 8;
__host__ __device__ __forceinline__ int lds_byte(int r, int c) { const int st = (r >> 4) * 2 + (c >> 5), rr = r & 15, cc = c & 31, ob = rr * 64 + cc * 2; return st * 1024 + (ob ^ (((ob >> 9) & 1) << 5)); }
__host__ __device__ __forceinline__ void stage_rc(int b, int& R, int& C) { const int st = b / 1024, sb = b % 1024, swz = sb ^ (((sb >> 9) & 1) << 5); R = (st >> 1) * 16 + swz / 64; C = (st & 1) * 32 + (swz % 64) / 2; }
__host__ __device__ __forceinline__ int perm32(int rho) { const int n = rho >> 4, i = rho & 15; return 8 * (i >> 2) + 4 * n + (i & 3); }
struct Unit { int pm, pn; };
struct Gemm { const bf16_t* A; const bf16_t* Bt; int M, N, K, lda, ldb; };
struct StaticOrder {
    int nM, nN, nwg, G, c;
    __device__ void init(int M, int N, int G_, int c_) { nM = M / BM; nN = N / BM; nwg = nM * nN; G = G_; c = c_; }
    __device__ bool next(int i, Unit& u) const {
        const long L = (long)i * G + c; if (L >= nwg) return false;
        int wgid = (int)L; { const int q = nwg / NXCD, r = nwg % NXCD, xcd = wgid % NXCD, off = wgid / NXCD; wgid = (xcd < r ? xcd * (q + 1) : r * (q + 1) + (xcd - r) * q) + off; }
        const int nig = WGM * nN, gid = wgid / nig, fm = gid * WGM, gsz = (nM - fm) < WGM ? (nM - fm) : WGM;
        u.pm = fm + ((wgid % nig) % gsz); u.pn = (wgid % nig) / gsz; return true;
    }
};

template <class Epi>
__device__ __forceinline__ void gemm_phase(PG8_LAS unsigned char* lds, const Gemm g, const StaticOrder& S, const Epi& E) {
    const int tid = threadIdx.x, wid = __builtin_amdgcn_readfirstlane(tid >> 6), lane = tid & 63, wr = wid >> 2, wc = wid & 3, fr = lane & 15, fq = lane >> 4;
    const int K = g.K, nt = K / BK;
    unsigned voffA[2], voffB[2];
#pragma unroll
    for (int i = 0; i < 2; ++i) { int R, C; stage_rc(tid * 16 + i * 8192, R, C); const int Rb = Epi::PERM ? ((R & ~31) + perm32(R & 31)) : R;
        voffA[i] = (unsigned)(R * g.lda + C) * 2u; voffB[i] = (unsigned)(Rb * g.ldb + C) * 2u; }
    const size_t kstep = (size_t)(BK * 2);
    const size_t hstepA = (size_t)HALF * g.lda * 2, hstepB = (size_t)HALF * g.ldb * 2;
    const size_t tstepA = 2 * hstepA, tstepB = 2 * hstepB;
    const unsigned ldsw = (unsigned)wid * 1024u;
    const int aoff = lds_byte(wr * 64 + fr, fq * 8), boff = lds_byte(wc * 32 + fr, fq * 8);
#define PG8_SA(b, h) (((b) * 2 + (h)) * HTB)
#define PG8_SB(b, h) ((4 + (b) * 2 + (h)) * HTB)
#define PG8_STAGE(bufoff, gbase, voff) do { _Pragma("unroll") for (int _i = 0; _i < 2; ++_i) \
        __builtin_amdgcn_global_load_lds((const unsigned*)((const char*)(gbase) + (voff)[_i]), (PG8_LAS unsigned*)(lds + (bufoff) + ldsw + _i * 8192), 16, 0, 0); } while (0)
#define PG8_LDA(dst, b, h) do { _Pragma("unroll") for (int m = 0; m < 4; ++m) _Pragma("unroll") for (int k = 0; k < 2; ++k) dst[m][k] = *(const PG8_LAS bf16x8*)(lds + PG8_SA(b, h) + aoff + m * 2048 + k * 1024); } while (0)
#define PG8_LDB(dst, b, h) do { _Pragma("unroll") for (int n = 0; n < 2; ++n) _Pragma("unroll") for (int k = 0; k < 2; ++k) dst[n][k] = *(const PG8_LAS bf16x8*)(lds + PG8_SB(b, h) + boff + n * 2048 + k * 1024); } while (0)
#define PG8_MMA(ai, bj, At, Bt) do { __builtin_amdgcn_s_setprio(1); _Pragma("unroll") for (int m = 0; m < 4; ++m) _Pragma("unroll") for (int n = 0; n < 2; ++n) _Pragma("unroll") for (int k = 0; k < 2; ++k) \
        acc[ai][bj][m][n] = __builtin_amdgcn_mfma_f32_16x16x32_bf16(Bt[n][k], At[m][k], acc[ai][bj][m][n], 0, 0, 0); __builtin_amdgcn_s_setprio(0); } while (0)
#define PG8_WAIT_V(n) asm volatile("s_waitcnt vmcnt(" #n ")" ::: "memory")
#define PG8_WAIT_L(n) asm volatile("s_waitcnt lgkmcnt(" #n ")" ::: "memory")
#define PG8_BAR __builtin_amdgcn_s_barrier()
#define PG8_SCHED __builtin_amdgcn_sched_barrier(0)
    Unit cur, nxt; int ui = 0;
    if (!S.next(0, cur)) return;
    f32x4 acc[2][2][4][2];
#pragma unroll
    for (int a = 0; a < 2; ++a)
#pragma unroll
        for (int b = 0; b < 2; ++b)
#pragma unroll
            for (int m = 0; m < 4; ++m)
#pragma unroll
                for (int n = 0; n < 2; ++n) acc[a][b][m][n] = (f32x4){0.f, 0.f, 0.f, 0.f};
    bf16x8 At[4][2], B0[2][2], B1[2][2];
    const char* cA = (const char*)g.A + (size_t)cur.pm * tstepA; const char* cB = (const char*)g.Bt + (size_t)cur.pn * tstepB;
    PG8_STAGE(PG8_SB(0, 0), cB, voffB); PG8_STAGE(PG8_SA(0, 0), cA, voffA); PG8_STAGE(PG8_SB(0, 1), cB + hstepB, voffB); PG8_STAGE(PG8_SA(0, 1), cA + hstepA, voffA);
    if (wr == 1) PG8_BAR;
    PG8_WAIT_V(4); PG8_BAR;
    PG8_STAGE(PG8_SB(1, 0), cB + kstep, voffB); PG8_STAGE(PG8_SA(1, 0), cA + kstep, voffA); PG8_STAGE(PG8_SB(1, 1), cB + hstepB + kstep, voffB);
    PG8_WAIT_V(6); PG8_BAR;
    for (;;) {
        const bool has_next = S.next(ui + 1, nxt);
        const char* nA = has_next ? (const char*)g.A + (size_t)nxt.pm * tstepA : cA; const char* nB = has_next ? (const char*)g.Bt + (size_t)nxt.pn * tstepB : cB;
        for (int t = 0; t < nt; t += 2) {
            const bool last = (t == nt - 2);
            const char* a1 = cA + (size_t)(t + 1) * kstep;
            const char* a2 = last ? nA : cA + (size_t)(t + 2) * kstep; const char* b2 = last ? nB : cB + (size_t)(t + 2) * kstep;
            const char* a3 = a2 + kstep; const char* b3 = b2 + kstep;
            PG8_LDB(B0, 0, 0); PG8_SCHED; PG8_LDA(At, 0, 0); PG8_STAGE(PG8_SA(1, 1), a1 + hstepA, voffA);
            PG8_WAIT_L(8); PG8_BAR; PG8_WAIT_L(0); PG8_MMA(0, 0, At, B0); PG8_BAR; PG8_SCHED;
            PG8_LDB(B1, 0, 1); PG8_STAGE(PG8_SB(0, 0), b2, voffB);
            PG8_BAR; PG8_WAIT_L(0); PG8_MMA(0, 1, At, B1); PG8_BAR;
            PG8_LDA(At, 0, 1); PG8_STAGE(PG8_SA(0, 0), a2, voffA);
            PG8_BAR; PG8_WAIT_L(0); PG8_MMA(1, 0, At, B0); PG8_BAR; PG8_SCHED;
            PG8_STAGE(PG8_SB(0, 1), b2 + hstepB, voffB);
            PG8_WAIT_V(6); PG8_BAR; PG8_MMA(1, 1, At, B1); PG8_BAR;
            PG8_LDB(B0, 1, 0); PG8_SCHED; PG8_LDA(At, 1, 0); PG8_STAGE(PG8_SA(0, 1), a2 + hstepA, voffA);
            PG8_WAIT_L(8); PG8_BAR; PG8_WAIT_L(0); PG8_MMA(0, 0, At, B0); PG8_BAR; PG8_SCHED;
            PG8_LDB(B1, 1, 1); PG8_STAGE(PG8_SB(1, 0), b3, voffB);
            PG8_BAR; PG8_WAIT_L(0); PG8_MMA(0, 1, At, B1); PG8_BAR;
            PG8_LDA(At, 1, 1); PG8_STAGE(PG8_SA(1, 0), a3, voffA);
            PG8_BAR; PG8_WAIT_L(0); PG8_MMA(1, 0, At, B0); PG8_BAR; PG8_SCHED;
            PG8_STAGE(PG8_SB(1, 1), b3 + hstepB, voffB);
            PG8_WAIT_V(6); PG8_BAR; PG8_MMA(1, 1, At, B1); PG8_BAR;
        }
        E(acc, cur, wr, wc, fr, fq);
        if (!has_next) break;
#pragma unroll
        for (int a = 0; a < 2; ++a)
#pragma unroll
            for (int b = 0; b < 2; ++b)
#pragma unroll
                for (int m = 0; m < 4; ++m)
#pragma unroll
                    for (int n = 0; n < 2; ++n) acc[a][b][m][n] = (f32x4){0.f, 0.f, 0.f, 0.f};
        cur = nxt; cA = nA; cB = nB; ++ui;
    }
    PG8_WAIT_V(0);
    if (wr == 0) PG8_BAR;
    PG8_BAR;
#undef PG8_SA
#undef PG8_SB
#undef PG8_STAGE
#undef PG8_LDA
#undef PG8_LDB
#undef PG8_MMA
#undef PG8_WAIT_V
#undef PG8_WAIT_L
#undef PG8_BAR
#undef PG8_SCHED
}
}

struct EpiGU {
    static constexpr bool PERM = true;
    bf16_t* act; const float* part; PG8_LAS float* rs_lds; mutable int cached_pm;
    __device__ __forceinline__ void operator()(const f32x4 (&acc)[2][2][4][2], const pg8::Unit& u, int wr, int wc, int fr, int fq) const {
        const int row0 = u.pm * 256 + wr * 64 + fr, col0 = u.pn * 128 + wc * 32 + 8 * fq;
        float rsv[8]; PG8_LAS float* mine = rs_lds + (wr * 4 + wc) * 512 + fq * 16 + fr;
        if (u.pm != cached_pm) { rstd8(part, row0, fq, rsv);
#pragma unroll
            for (int k = 0; k < 8; ++k) mine[k * 64] = rsv[k];
            cached_pm = u.pm; }
        else {
#pragma unroll
            for (int k = 0; k < 8; ++k) rsv[k] = mine[k * 64]; }
#pragma unroll
        for (int ai = 0; ai < 2; ++ai)
#pragma unroll
            for (int m = 0; m < 4; ++m) {
                const int r = row0 + ai * 128 + m * 16; const float rs = rsv[ai * 4 + m];
                float o[8];
#pragma unroll
                for (int n = 0; n < 2; ++n)
#pragma unroll
                    for (int i = 0; i < 4; ++i) { const float gv = acc[ai][0][m][n][i] * rs, uv = acc[ai][1][m][n][i] * rs; o[n * 4 + i] = gv * sigmoidf_(gv) * uv; }
                *(u32x4*)(act + (size_t)r * DFF + col0) = pack8(o);
            }
    }
};
struct EpiRes {
    static constexpr bool PERM = true;
    const bf16_t* resb; float* outf; bf16_t* hb; float* part; float coef;
    __device__ __forceinline__ void operator()(const f32x4 (&acc)[2][2][4][2], const pg8::Unit& u, int wr, int wc, int fr, int fq) const {
        const int row0 = u.pm * 256 + wr * 64 + fr, col0 = u.pn * 256 + wc * 32 + 8 * fq;
#pragma unroll
        for (int ai = 0; ai < 2; ++ai) {
            u32x4 rb[4][2];
#pragma unroll
            for (int m = 0; m < 4; ++m)
#pragma unroll
                for (int bj = 0; bj < 2; ++bj) rb[m][bj] = *(const u32x4*)(resb + (size_t)(row0 + ai * 128 + m * 16) * DM + col0 + bj * 128);
#pragma unroll
            for (int m = 0; m < 4; ++m) {
                const int r = row0 + ai * 128 + m * 16; float ss = 0.f;
#pragma unroll
                for (int bj = 0; bj < 2; ++bj) {
                    const size_t off = (size_t)r * DM + col0 + bj * 128;
                    float rv[8], o[8]; unpack8(rb[m][bj], rv);
#pragma unroll
                    for (int n = 0; n < 2; ++n)
#pragma unroll
                        for (int i = 0; i < 4; ++i) o[n * 4 + i] = rv[n * 4 + i] + coef * acc[ai][bj][m][n][i];
                    if (outf) { __builtin_nontemporal_store((f32x4){o[0], o[1], o[2], o[3]}, (f32x4*)(outf + off)); __builtin_nontemporal_store((f32x4){o[4], o[5], o[6], o[7]}, (f32x4*)(outf + off + 4)); }
                    if (hb) { *(u32x4*)(hb + off) = pack8(o);
#pragma unroll
                        for (int i = 0; i < 8; ++i) ss += o[i] * o[i]; }
                }
                if (hb) { ss += __shfl_xor(ss, 16); ss += __shfl_xor(ss, 32); if (fq == 0) part[(size_t)r * 32 + u.pn * 4 + wc] = ss; }
            }
        }
    }
};
struct EpiZ {
    static constexpr bool PERM = true;
    bf16_t* Z1; bf16_t* XCC; bf16_t* BB; bf16_t* G; const float* part; const float* partm; PG8_LAS float* rs_lds; mutable int cached_pm;
    __device__ __forceinline__ void operator()(const f32x4 (&acc)[2][2][4][2], const pg8::Unit& u, int wr, int wc, int fr, int fq) const {
        const int row0 = u.pm * 256 + wr * 64 + fr; const int pn = u.pn;
        bf16_t* base; int ld, cb; const bool paired = (pn >= 11 && pn < 19);
        if (pn < 11) { base = Z1; ld = LDZ; cb = pn * 256; } else if (pn < 19) { base = XCC; ld = LDX; cb = (pn - 11) * 128; } else if (pn < 23) { base = BB; ld = LDX; cb = (pn - 19) * 256; } else { base = G; ld = LDG; cb = (pn - 23) * 256; }
        cb += wc * 32 + 8 * fq;
        float rsv[8]; PG8_LAS float* mine = rs_lds + (wr * 4 + wc) * 512 + fq * 16 + fr;
        if (u.pm < 64 && u.pm == cached_pm) {
#pragma unroll
            for (int k = 0; k < 8; ++k) rsv[k] = mine[k * 64]; }
        else if (u.pm < 64) { rstd8(part, row0, fq, rsv);
#pragma unroll
            for (int k = 0; k < 8; ++k) mine[k * 64] = rsv[k];
            cached_pm = u.pm; }
        else {
#pragma unroll
            for (int k = 0; k < 8; ++k) rsv[k] = 0.f;
            const f32x4* pp = (const f32x4*)(partm + fr * 128 + fq * 32); float sm = 0.f;
#pragma unroll
            for (int i = 0; i < 8; ++i) { const f32x4 v = pp[i]; sm += (v[0] + v[1]) + (v[2] + v[3]); }
            sm += __shfl_xor(sm, 16); sm += __shfl_xor(sm, 32);
            if (wr == 0) rsv[0] = rsqrtf(sm * (1.0f / 2048.0f) + EPS);
        }
#pragma unroll
        for (int ai = 0; ai < 2; ++ai)
#pragma unroll
            for (int m = 0; m < 4; ++m) {
                const int r = row0 + ai * 128 + m * 16; const float rs = rsv[ai * 4 + m];
                bf16_t* rowp = base + (size_t)r * ld + cb;
                if (paired) {
                    float o[8]; const float rs2 = rs * rs;
#pragma unroll
                    for (int n = 0; n < 2; ++n)
#pragma unroll
                        for (int i = 0; i < 4; ++i) o[n * 4 + i] = acc[ai][0][m][n][i] * acc[ai][1][m][n][i] * rs2;
                    *(u32x4*)rowp = pack8(o);
                } else {
#pragma unroll
                    for (int bj = 0; bj < 2; ++bj) { float o[8];
#pragma unroll
                        for (int n = 0; n < 2; ++n)
#pragma unroll
                            for (int i = 0; i < 4; ++i) o[n * 4 + i] = acc[ai][bj][m][n][i] * rs;
                        *(u32x4*)(rowp + bj * 128) = pack8(o); }
                }
            }
    }
};
struct EpiGate {
    static constexpr bool PERM = true;
    bf16_t* G; int mode;
    __device__ __forceinline__ void operator()(const f32x4 (&acc)[2][2][4][2], const pg8::Unit& u, int wr, int wc, int fr, int fq) const {
        const int row0 = u.pm * 256 + wr * 64 + fr, col0 = u.pn * 256 + wc * 32 + 8 * fq;
#pragma unroll
        for (int ai = 0; ai < 2; ++ai) {
            u32x4 la[4][2], lg[4][2];
#pragma unroll
            for (int m = 0; m < 4; ++m)
#pragma unroll
                for (int bj = 0; bj < 2; ++bj) { const bf16_t* p = G + (size_t)(row0 + ai * 128 + m * 16) * LDG + col0 + bj * 128;
                    la[m][bj] = *(const u32x4*)p; if (mode != 0) lg[m][bj] = *(const u32x4*)(p + 2048); else lg[m][bj] = la[m][bj]; }
#pragma unroll
            for (int m = 0; m < 4; ++m)
#pragma unroll
                for (int bj = 0; bj < 2; ++bj) {
                    bf16_t* p = G + (size_t)(row0 + ai * 128 + m * 16) * LDG + col0 + bj * 128;
                    float a[8], gt[8], o[8];
                    unpack8(la[m][bj], a);
                    if (mode == 0) {
#pragma unroll
                        for (int n = 0; n < 2; ++n)
#pragma unroll
                            for (int i = 0; i < 4; ++i) o[n * 4 + i] = sigmoidf_(a[n * 4 + i]) * acc[ai][bj][m][n][i];
                    } else {
                        unpack8(lg[m][bj], gt);
#pragma unroll
                        for (int n = 0; n < 2; ++n)
#pragma unroll
                            for (int i = 0; i < 4; ++i) o[n * 4 + i] = a[n * 4 + i] + sigmoidf_(gt[n * 4 + i]) * acc[ai][bj][m][n][i];
                    }
                    *(u32x4*)p = pack8(o);
                }
        }
    }
};

template <bool PAIR, int STEPS, class F>
__device__ __forceinline__ void skinny16(const bf16_t* A, int lda, const bf16_t* Bt, int K, int ntasks, unsigned char* lds, F&& epi) {
    const int lane = threadIdx.x & 63, wv_ = threadIdx.x >> 6, r = lane & 15, kq = lane >> 4;
    f32x4* red = (f32x4*)lds;
    for (int task = blockIdx.x; task < ntasks; task += gridDim.x) {
        int n0, n1;
        if (PAIR) { n0 = (task >> 3) * 256 + (task & 7) * 16; n1 = n0 + 128; } else { n0 = task * 16; n1 = n0; }
        const int kbeg = wv_ * STEPS * 32;
        const bf16_t* ap = A + (size_t)r * lda + kbeg + kq * 8;
        const bf16_t* b0 = Bt + (size_t)(n0 + r) * K + kbeg + kq * 8;
        const bf16_t* b1 = Bt + (size_t)(n1 + r) * K + kbeg + kq * 8;
        f32x4 acc0 = {0.f, 0.f, 0.f, 0.f}, acc1 = {0.f, 0.f, 0.f, 0.f};
#pragma unroll
        for (int st = 0; st < STEPS; ++st) {
            const bf16x8 a = *(const bf16x8*)(ap + st * 32), x0 = *(const bf16x8*)(b0 + st * 32);
            acc0 = __builtin_amdgcn_mfma_f32_16x16x32_bf16(a, x0, acc0, 0, 0, 0);
            if (PAIR) { const bf16x8 x1 = *(const bf16x8*)(b1 + st * 32); acc1 = __builtin_amdgcn_mfma_f32_16x16x32_bf16(a, x1, acc1, 0, 0, 0); }
        }
        red[(wv_ * 2 + 0) * 64 + lane] = acc0; if (PAIR) red[(wv_ * 2 + 1) * 64 + lane] = acc1;
        __syncthreads();
        if (wv_ == 0) {
            f32x4 s0 = red[lane], s1 = {0.f, 0.f, 0.f, 0.f}; if (PAIR) s1 = red[64 + lane];
#pragma unroll
            for (int w = 1; w < 8; ++w) { s0 += red[(w * 2) * 64 + lane]; if (PAIR) s1 += red[(w * 2 + 1) * 64 + lane]; }
            epi(s0, s1, task, n0, r, kq);
        }
        __syncthreads();
    }
}

struct ConvJob { const float* W0; const float* W1; const float* g; bf16_t* dst; int ldw, K, N, mode; };
__device__ __forceinline__ void convert_unit(const ConvJob& J, int u, int lane) {
    const int nkb = J.K / 32;
    {
        const int ch = u / nkb, kb = u % nkb;
        const int n = ch * 256 + lane * 4; const float* src = J.W0; int col = n;
        if (J.mode == 1) { col = (n >> 8) * 128 + (n & 127); if ((n >> 7) & 1) src = J.W1; }
        else if (J.mode == 2) { const int pn = n >> 8;
            if (pn < 11) col = (n < 2640) ? n : -1;
            else if (pn < 19) col = (((n >> 7) & 1) ? 4688 : 2640) + (pn - 11) * 128 + (n & 127);
            else if (pn < 23) col = 3664 + (n - 19 * 256);
            else col = 5712 + (n - 23 * 256); }
        const float* sp = src + (size_t)(kb * 32) * J.ldw + (col >= 0 ? col : 0);
        f32x4 v[4][8];
#pragma unroll
        for (int it = 0; it < 4; ++it)
#pragma unroll
            for (int i = 0; i < 8; ++i) v[it][i] = __builtin_nontemporal_load((const f32x4*)(sp + (size_t)(it * 8 + i) * J.ldw));
        if (col < 0) {
#pragma unroll
            for (int it = 0; it < 4; ++it)
#pragma unroll
                for (int i = 0; i < 8; ++i) v[it][i] = (f32x4){0.f, 0.f, 0.f, 0.f}; }
        if (J.g) {
#pragma unroll
            for (int it = 0; it < 4; ++it)
#pragma unroll
                for (int i = 0; i < 8; ++i) v[it][i] *= J.g[kb * 32 + it * 8 + i]; }
        bf16_t* dp = J.dst + (size_t)n * J.K + kb * 32;
#pragma unroll
        for (int jn = 0; jn < 4; ++jn)
#pragma unroll
            for (int it = 0; it < 4; ++it) { u32x4 w; w.x = cvt_pk_bf16(v[it][0][jn], v[it][1][jn]); w.y = cvt_pk_bf16(v[it][2][jn], v[it][3][jn]); w.z = cvt_pk_bf16(v[it][4][jn], v[it][5][jn]); w.w = cvt_pk_bf16(v[it][6][jn], v[it][7][jn]);
                *(u32x4*)(dp + (size_t)jn * J.K + it * 8) = w; }
    }
}

struct Params {
    const float* x; const float* meta; const float* g1; const float* wg1; const float* wu1; const float* wd1;
    const float* gm; const float* win; const float* qg; const float* kg; const float* cw; const float* cbias;
    const float* wa; const float* wc; const float* wo; const float* g2; const float* wg2; const float* wu2; const float* wd2;
    float* out; unsigned char* ws;
};

__device__ __forceinline__ int key_row(int b, int t) { return t < NMETA ? MMAIN + t : b * SEQ + t - NMETA; }

__device__ __forceinline__ void sincos_d(double a, float& s_out, float& c_out) {
    const double TWO_PI = 6.283185307179586476925286766559, INV = 0.15915494309189533576888376337251;
    const double n = rint(a * INV); double r = a - n * TWO_PI;
    const double y = 0.5 * r, y2 = y * y;
    double s = 1.0, c = 1.0, ts = 1.0, tc = 1.0;
#pragma unroll
    for (int k = 1; k <= 12; ++k) { tc *= -y2 / (double)((2 * k - 1) * (2 * k)); ts *= -y2 / (double)((2 * k) * (2 * k + 1)); c += tc; s += ts; }
    s *= y;
    s_out = (float)(2.0 * s * c); c_out = (float)(1.0 - 2.0 * s * s);
}

__device__ __forceinline__ void phase_prep(const Params& P, unsigned char* lds) {
    unsigned char* ws = P.ws;
    const int tid = threadIdx.x, lane = tid & 63, wave = tid >> 6;
    { float* rope = (float*)(ws + WS_ROPE);
      for (int idx = blockIdx.x * 512 + tid; idx < TT * 24; idx += gridDim.x * 512) {
          const int t = idx / 24, f = idx % 24; float inv;
          if (f < 16) inv = (float)exp2(-((double)(2 * f) / 32.0) * 18.931568569324174);
          else inv = (float)exp2(-((double)(2 * (f - 16)) / 16.0) * 18.931568569324174);
          const float ang = (float)t * inv; float s, c; sincos_d((double)ang, s, c);
          if (f < 16) { rope[t * 48 + f] = c; rope[t * 48 + 16 + f] = s; } else { rope[t * 48 + 32 + (f - 16)] = c; rope[t * 48 + 40 + (f - 16)] = s; }
      } }
    { bf16_t* HB = (bf16_t*)(ws + WS_HB); float* part = (float*)(ws + WS_PART); float* hmeta = (float*)(ws + WS_HMETA);
      for (int r = blockIdx.x * 8 + wave; r < MPAD; r += gridDim.x * 8) {
          const float* src = r < MMAIN ? P.x + (size_t)r * DM : (r < MMAIN + NMETA ? P.meta + (size_t)(r - MMAIN) * DM : nullptr);
          float ss = 0.f;
#pragma unroll
          for (int i = 0; i < 8; ++i) { const int c = i * 256 + lane * 4; f32x4 v = src ? __builtin_nontemporal_load((const f32x4*)(src + c)) : (f32x4){0.f, 0.f, 0.f, 0.f};
              ss += (v[0] * v[0] + v[1] * v[1]) + (v[2] * v[2] + v[3] * v[3]);
              u32x2 w; w.x = cvt_pk_bf16(v[0], v[1]); w.y = cvt_pk_bf16(v[2], v[3]); *(u32x2*)(HB + (size_t)r * DM + c) = w;
              if (r >= MMAIN) *(f32x4*)(hmeta + (size_t)(r - MMAIN) * DM + c) = v; }
#pragma unroll
          for (int o = 32; o >= 1; o >>= 1) ss += __shfl_xor(ss, o);
          if (lane < 32) part[(size_t)r * 32 + lane] = (lane == 0) ? ss : 0.f;
      } }
    {
        unsigned char* w = ws;
        const int lane_ = tid & 63, gw = blockIdx.x * 8 + wave, nw = gridDim.x * 8;
        constexpr int U0 = 44 * 64, U1 = U0 + 8 * 176, U2 = U1 + 44 * 64, U3 = U2 + 8 * 176, U4 = U3 + 39 * 64, U5 = U4 + 8 * 32, U6 = U5 + 8 * 32, U7 = U6 + 8 * 64;
        for (int u = gw; u < U7; u += nw) {
            if (u < U0)      { ConvJob J{P.wg1, P.wu1, P.g1, (bf16_t*)(w + WS_WGU), DFF, DM, 11264, 1}; convert_unit(J, u, lane_); }
            else if (u < U1) { ConvJob J{P.wd1, nullptr, nullptr, (bf16_t*)(w + WS_WD), DM, DFF, 2048, 0}; convert_unit(J, u - U0, lane_); }
            else if (u < U2) { ConvJob J{P.wg2, P.wu2, P.g2, (bf16_t*)(w + WS_WGU2), DFF, DM, 11264, 1}; convert_unit(J, u - U1, lane_); }
            else if (u < U3) { ConvJob J{P.wd2, nullptr, nullptr, (bf16_t*)(w + WS_WD2), DM, DFF, 2048, 0}; convert_unit(J, u - U2, lane_); }
            else if (u < U4) { ConvJob J{P.win, nullptr, P.gm, (bf16_t*)(w + WS_WIN), 9808, DM, NIN, 2}; convert_unit(J, u - U3, lane_); }
            else if (u < U5) { ConvJob J{P.wa, nullptr, nullptr, (bf16_t*)(w + WS_WA), DM, 1024, 2048, 0}; convert_unit(J, u - U4, lane_); }
            else if (u < U6) { ConvJob J{P.wc, nullptr, nullptr, (bf16_t*)(w + WS_WC), DM, 1024, 2048, 0}; convert_unit(J, u - U5, lane_); }
            else             { ConvJob J{P.wo, nullptr, nullptr, (bf16_t*)(w + WS_WO), DM, DM, 2048, 0}; convert_unit(J, u - U6, lane_); }
        }
    }
}

__device__ __forceinline__ void norm_rope16(u32x4& w0, u32x4& w1, const f32x4 (&gn)[4], const f32x4 (&cs)[8], int part) {
    float v[16];
    { float a[8], b[8]; unpack8(w0, a); unpack8(w1, b);
#pragma unroll
      for (int i = 0; i < 8; ++i) { v[i] = a[i]; v[8 + i] = b[i]; } }
    float ss = 0.f;
#pragma unroll
    for (int i = 0; i < 16; ++i) ss += v[i] * v[i];
    ss += __shfl_xor(ss, 1); ss += __shfl_xor(ss, 2); ss += __shfl_xor(ss, 4);
    const float rs = rsqrtf(ss * (1.0f / 128.0f) + EPS);
    float y[16];
#pragma unroll
    for (int i = 0; i < 16; ++i) y[i] = v[i] * rs * gn[i >> 2][i & 3];
#pragma unroll
    for (int i = 0; i < 16; ++i) { const float other = __shfl_xor(y[i], 1);
        if (part < 2) { const float c = cs[i >> 2][i & 3], sn = cs[4 + (i >> 2)][i & 3];
            y[i] = (part == 0) ? (y[i] * c - other * sn) : (y[i] * c + other * sn); } }
    { float a[8], b[8];
#pragma unroll
      for (int i = 0; i < 8; ++i) { a[i] = y[i]; b[i] = y[8 + i]; }
      w0 = pack8(a); w1 = pack8(b); }
}
__device__ __forceinline__ void rope_idx16(u32x4& w0, u32x4& w1, const f32x4 (&ci)[4]  ) {
    float a[8], b[8]; unpack8(w0, a); unpack8(w1, b);
    float r1[8], r2[8];
#pragma unroll
    for (int i = 0; i < 8; ++i) { const float c = ci[i >> 2][i & 3], sn = ci[2 + (i >> 2)][i & 3]; r1[i] = a[i] * c - b[i] * sn; r2[i] = b[i] * c + a[i] * sn; }
    w0 = pack8(r1); w1 = pack8(r2);
}
__device__ __forceinline__ void phase_post(const Params& P, unsigned char* lds) {
    unsigned char* ws = P.ws;
    bf16_t* Z1 = (bf16_t*)(ws + WS_Z1); bf16_t* XCC = (bf16_t*)(ws + WS_XCC); bf16_t* BB = (bf16_t*)(ws + WS_BB); bf16_t* HB = (bf16_t*)(ws + WS_HB);
    bf16_t* VT = (bf16_t*)(ws + WS_VT); const float* rope = (const float*)(ws + WS_ROPE);
    const int tid = threadIdx.x, lane = tid & 63, wave = tid >> 6;
    bf16_t* vt_l = (bf16_t*)lds;
    float* tq = (float*)(lds + 16384); float* tk = tq + 128; float* tcw = tk + 128; float* tcb = tcw + 3072;
    for (int i = tid; i < 128 + 128 + 3072 + 1024; i += 512) tq[i] = i < 128 ? P.qg[i] : (i < 256 ? P.kg[i - 128] : (i < 3328 ? P.cw[i - 256] : P.cbias[i - 3328]));
    __syncthreads();
    for (int blk = blockIdx.x; blk < 513; blk += gridDim.x) {
        const bool mblk = (blk == 512);
        const int b = blk >> 6, j = blk & 63;
        const int nrows = mblk ? 16 : 32, rbase = mblk ? MMAIN : b * SEQ + j * 32, t0 = mblk ? 0 : j * 32 + NMETA;
        for (int rl = wave; rl < nrows; rl += 8) {
            const int r = rbase + rl, t = t0 + rl; const float* rt = rope + (size_t)t * 48;
            bf16_t* zr = Z1 + (size_t)r * LDZ;
            bf16_t* qp = zr + 16 * lane; bf16_t* kp = zr + 1024 + 16 * (lane & 15); bf16_t* ip = zr + 1536 + 16 * lane; bf16_t* jp = zr + 2560 + 16 * (lane & 3);
            u32x4 q0 = *(const u32x4*)qp, q1 = *(const u32x4*)(qp + 8), k0 = *(const u32x4*)kp, k1 = *(const u32x4*)(kp + 8);
            u32x4 i0 = *(const u32x4*)ip, i1 = *(const u32x4*)(ip + 8), j0 = *(const u32x4*)jp, j1 = *(const u32x4*)(jp + 8);
            const u32x4 vv = *(const u32x4*)(zr + 1280 + (lane & 31) * 8);
            f32x4 cs[8], ci[4];
#pragma unroll
            for (int i = 0; i < 8; ++i) cs[i] = *(const f32x4*)(rt + 4 * i);
#pragma unroll
            for (int i = 0; i < 4; ++i) ci[i] = *(const f32x4*)(rt + 32 + 4 * i);
            if (!mblk) {
                const int c = lane * 16;
                const int sidx = r & (SEQ - 1);
                const int r1 = sidx >= 1 ? r - 1 : MMAIN + 15, r2 = sidx >= 2 ? r - 2 : MMAIN + 14 + sidx;
                u32x4 x0[2], x1[2], x2[2], bv[2]; f32x4 cw0[4], cw1[4], cw2[4], cb[4];
#pragma unroll
                for (int hq = 0; hq < 2; ++hq) { x0[hq] = *(const u32x4*)(XCC + (size_t)r * LDX + c + hq * 8); x1[hq] = *(const u32x4*)(XCC + (size_t)r1 * LDX + c + hq * 8);
                    x2[hq] = *(const u32x4*)(XCC + (size_t)r2 * LDX + c + hq * 8); bv[hq] = *(const u32x4*)(BB + (size_t)r * LDX + c + hq * 8); }
#pragma unroll
                for (int i = 0; i < 4; ++i) { cw0[i] = *(const f32x4*)(tcw + c + 4 * i); cw1[i] = *(const f32x4*)(tcw + 1024 + c + 4 * i); cw2[i] = *(const f32x4*)(tcw + 2048 + c + 4 * i); cb[i] = *(const f32x4*)(tcb + c + 4 * i); }
#pragma unroll
                for (int hq = 0; hq < 2; ++hq) { float a0[8], a1[8], a2[8], ab[8], o[8];
                    unpack8(x0[hq], a0); unpack8(x1[hq], a1); unpack8(x2[hq], a2); unpack8(bv[hq], ab);
#pragma unroll
                    for (int i = 0; i < 8; ++i) { const int q4 = hq * 2 + (i >> 2), e = i & 3;
                        const float y = cw0[q4][e] * a2[i] + cw1[q4][e] * a1[i] + cw2[q4][e] * a0[i] + cb[q4][e]; o[i] = ab[i] * y; }
                    *(u32x4*)(BB + (size_t)r * LDX + c + hq * 8) = pack8(o); }
            }
            f32x4 gq[4], gk[4];
#pragma unroll
            for (int i = 0; i < 4; ++i) { gq[i] = *(const f32x4*)(tq + (lane & 7) * 16 + 4 * i); gk[i] = *(const f32x4*)(tk + (lane & 7) * 16 + 4 * i); }
            norm_rope16(q0, q1, gq, cs, lane & 7);
            norm_rope16(k0, k1, gk, cs, lane & 7);
            rope_idx16(i0, i1, ci);
            const u32x4 j0raw = j0, j1raw = j1;
            rope_idx16(j0, j1, ci);
            *(u32x4*)qp = q0; *(u32x4*)(qp + 8) = q1;
            if (lane < 16) { *(u32x4*)kp = k0; *(u32x4*)(kp + 8) = k1; }
            if ((lane & 3) == 0) { *(u32x4*)ip = i0; *(u32x4*)(ip + 8) = i1; }
            if (lane == 0) { *(u32x4*)jp = j0; *(u32x4*)(jp + 8) = j1; }
            if (lane < 4) {
                const int half = lane >> 1, kk0 = 2 * (lane & 1);
                const int bb0 = mblk ? 0 : b, bb1 = mblk ? NBATCH : b + 1;
                for (int bb = bb0; bb < bb1; ++bb) {
                    unsigned char* kt = ws + WS_KI2 + ((size_t)bb * 65 + (t >> 5)) * 4096 + (half * 32 + (t & 31)) * 16;
                    *(u32x4*)(kt + kk0 * 1024) = (lane == 0) ? j0 : j0raw; *(u32x4*)(kt + (kk0 + 1) * 1024) = (lane == 0) ? j1 : j1raw; }
            }
            if (lane < 32) *(u32x4*)(vt_l + rl * 256 + lane * 8) = vv;
        }
        __syncthreads();
        { const int gd = tid >> 1, half = tid & 1;
          if (half * 16 < nrows) {
              unsigned w[8];
#pragma unroll
              for (int pp = 0; pp < 8; ++pp) { unsigned lo, hi;
                  { const int p0 = 2 * pp, kk = 8 * ((p0 >> 2) & 1) + 4 * (p0 >> 3) + (p0 & 3); lo = vt_l[(half * 16 + kk) * 256 + gd]; }
                  { const int p1 = 2 * pp + 1, kk = 8 * ((p1 >> 2) & 1) + 4 * (p1 >> 3) + (p1 & 3); hi = vt_l[(half * 16 + kk) * 256 + gd]; }
                  w[pp] = lo | (hi << 16); }
              u32x4 w0 = {w[0], w[1], w[2], w[3]}, w1 = {w[4], w[5], w[6], w[7]};
              const int bb0 = mblk ? 0 : b, bb1 = mblk ? NBATCH : b + 1;
              const int tpos = t0 + half * 16;
              for (int bb = bb0; bb < bb1; ++bb) { bf16_t* d = VT + (((size_t)bb * 65 + (tpos >> 5)) * 256 + gd) * 32 + (tpos & 31); *(u32x4*)d = w0; *(u32x4*)(d + 8) = w1; }
          }
          if (!mblk && j == 63 && half == 0) { bf16_t* d = VT + (((size_t)b * 65 + 64) * 256 + gd) * 32 + 16; u32x4 z = {0u, 0u, 0u, 0u}; *(u32x4*)d = z; *(u32x4*)(d + 8) = z; }
        }
        __syncthreads();
    }
}

__device__ __forceinline__ unsigned ordered_key(float f) { const unsigned u = __float_as_uint(f); return u ^ ((u >> 31) ? 0xffffffffu : 0x80000000u); }
constexpr int ATT_SC_OFF = 0, ATT_BM_OFF = 133120, ATT_K_OFF = 0, ATT_V_OFF = 32768;
__device__ __forceinline__ void phase_attn(const Params& P, unsigned char* lds) {
    unsigned char* ws = P.ws;
    const bf16_t* Z1 = (const bf16_t*)(ws + WS_Z1); const bf16_t* VT = (const bf16_t*)(ws + WS_VT); bf16_t* AO = (bf16_t*)(ws + WS_XCC);
    const int tid = threadIdx.x, lane = tid & 63, wave = tid >> 6, lr = lane & 31, hh = lane >> 5;
    unsigned* scU = (unsigned*)(lds + ATT_SC_OFF); unsigned* bm = (unsigned*)(lds + ATT_BM_OFF);
    for (int idx = blockIdx.x; idx < 512; idx += gridDim.x) {
        const int b = idx & 7; const int j = idx < 256 ? 63 - (idx >> 3) : ((idx - 256) >> 3);
        const int s0 = j * 32, ntiles = j + 2;
        for (int pp = 0; pp < 2; ++pp) {
            const int p = wave * 2 + pp; const int sq = s0 + 2 * p + hh; const int rowq = b * SEQ + sq;
            bf16x8 Aq[4];
            { const int qa = s0 + 2 * p + ((lr >> 2) & 1), ha = (lr & 3) + 4 * (lr >> 3);
              const bf16_t* ap = Z1 + (size_t)(b * SEQ + qa) * LDZ + 1536 + ha * 64 + hh * 32;
#pragma unroll
              for (int kk = 0; kk < 4; ++kk) Aq[kk] = *(const bf16x8*)(ap + kk * 8); }
            float wv[16];
            { float a[8], c[8]; unpack8(*(const u32x4*)(Z1 + (size_t)rowq * LDZ + 2624), a); unpack8(*(const u32x4*)(Z1 + (size_t)rowq * LDZ + 2632), c);
#pragma unroll
              for (int i = 0; i < 8; ++i) { wv[i] = a[i]; wv[8 + i] = c[i]; } }
            unsigned* myrow = scU + (wave * 2 + hh) * TPAD + lr;
            bf16x8 B0[4], B1[4], B2[4], B3[4];
#define IDX_LOAD(BUF, tl) do { const int tc_ = (tl) < 64 ? (tl) : 64; const unsigned char* bp_ = ws + WS_KI2 + ((size_t)b * 65 + tc_) * 4096 + (hh * 32 + lr) * 16; \
                _Pragma("unroll") for (int kk = 0; kk < 4; ++kk) BUF[kk] = *(const bf16x8*)(bp_ + kk * 1024); } while (0)
#define IDX_TILE(BUF, tl) do { const int t_ = (tl) * 32 + lr; f32x16 acc_; \
                _Pragma("unroll") for (int i = 0; i < 16; ++i) acc_[i] = 0.f; \
                _Pragma("unroll") for (int kk = 0; kk < 4; ++kk) acc_ = __builtin_amdgcn_mfma_f32_32x32x16_bf16(Aq[kk], BUF[kk], acc_, 0, 0, 0); \
                IDX_LOAD(BUF, (tl) + 4); \
                float sc_ = 0.f, sd_ = 0.f; \
                _Pragma("unroll") for (int i = 0; i < 16; i += 2) { sc_ += wv[i] * __int_as_float(max(__float_as_int(acc_[i]), 0)); sd_ += wv[i + 1] * __int_as_float(max(__float_as_int(acc_[i + 1]), 0)); } \
                sc_ += sd_; \
                myrow[(tl) * 32] = (t_ <= sq + NMETA) ? ordered_key(sc_) : 0u; } while (0)
            IDX_LOAD(B0, 0); IDX_LOAD(B1, 1); IDX_LOAD(B2, 2); IDX_LOAD(B3, 3);
            for (int tile = 0; tile < ntiles; tile += 4) {
                IDX_TILE(B0, tile);
                if (tile + 1 < ntiles) IDX_TILE(B1, tile + 1);
                if (tile + 2 < ntiles) IDX_TILE(B2, tile + 2);
                if (tile + 3 < ntiles) IDX_TILE(B3, tile + 3);
            }
#undef IDX_LOAD
#undef IDX_TILE
            const int nch = (ntiles + 7) >> 3;
            for (int tile = ntiles; tile < nch * 8 && tile < 65; ++tile) myrow[tile * 32] = 0u;
            unsigned key[72];
#pragma unroll
            for (int ch = 0; ch < 9; ++ch) {
                if (ch < nch) {
#pragma unroll
                    for (int jj = 0; jj < 8; ++jj) { const int jx = ch * 8 + jj; key[jx] = (jx < 65) ? myrow[jx * 32] : 0u; }
                } else {
#pragma unroll
                    for (int jj = 0; jj < 8; ++jj) key[ch * 8 + jj] = 0u;
                }
            }
            unsigned prefix = 0u;
            for (int bit = 31; bit >= 8; --bit) {
                const unsigned cand = prefix | (1u << bit); const int c31 = (int)(cand >> 1);
                int lt0 = 0, lt1 = 0;
#pragma unroll
                for (int ch = 0; ch < 9; ++ch) {
                    if (ch < nch) {
#pragma unroll
                        for (int jj = 0; jj < 8; jj += 2) { lt0 += (int)((unsigned)((int)(key[ch * 8 + jj] >> 1) - c31) >> 31); lt1 += (int)((unsigned)((int)(key[ch * 8 + jj + 1] >> 1) - c31) >> 31); }
                    }
                }
                int cnt = nch * 8 - (lt0 + lt1);
                cnt += __builtin_amdgcn_update_dpp(0, cnt, 0xB1, 0xF, 0xF, true);
                cnt += __builtin_amdgcn_update_dpp(0, cnt, 0x4E, 0xF, 0xF, true);
                cnt += __builtin_amdgcn_update_dpp(0, cnt, 0x141, 0xF, 0xF, true);
                cnt += __builtin_amdgcn_update_dpp(0, cnt, 0x140, 0xF, 0xF, true);
                cnt += __shfl_xor(cnt, 16);
                if (cnt >= 256) prefix = cand;
            }
            const unsigned thr = prefix > 1u ? prefix : 1u;
#pragma unroll
            for (int ch = 0; ch < 9; ++ch) {
                if (ch < nch) {
#pragma unroll
                    for (int jj = 0; jj < 8; ++jj) { const int jx = ch * 8 + jj;
                        if (jx < 65) { const unsigned long long bal = __ballot(key[jx] >= thr);
                            const unsigned word = hh ? (unsigned)(bal >> 32) : (unsigned)bal;
                            if (lr == 0) bm[(2 * p + hh) * 65 + jx] = word; } }
                }
            }
        }
        __syncthreads();
        {
            const int g = wave >> 2;
            bf16x8 Qf[8];
            { const bf16_t* qp = Z1 + (size_t)(b * SEQ + s0 + lr) * LDZ + wave * 128 + hh * 8;
#pragma unroll
              for (int kk = 0; kk < 8; ++kk) Qf[kk] = *(const bf16x8*)(qp + kk * 16); }
#pragma unroll
            for (int kk = 0; kk < 8; ++kk) asm volatile("" :: "v"(Qf[kk]));
            f32x16 o[4];
#pragma unroll
            for (int d = 0; d < 4; ++d)
#pragma unroll
                for (int i = 0; i < 16; ++i) o[d][i] = 0.f;
            float m = -1e30f, l = 0.f;
            const int kkey0 = tid >> 5, kch = tid & 31;
            const int vrow0 = tid >> 2, vc4 = tid & 3;
            u32x4 sKa[2], sVa[2], sKb[2], sVb[2];
#define ATT_LOAD(SK, SV, tile_) do { _Pragma("unroll") for (int i_ = 0; i_ < 2; ++i_) { const int key_ = kkey0 + 16 * i_; int t_ = (tile_) * 32 + key_; t_ = t_ < TT ? t_ : TT - 1; \
                SK[i_] = *(const u32x4*)(Z1 + (size_t)key_row(b, t_) * LDZ + 1024 + kch * 8); \
                SV[i_] = *(const u32x4*)(VT + (((size_t)b * 65 + (tile_)) * 256 + vrow0 + 128 * i_) * 32 + vc4 * 8); } } while (0)
#define ATT_STORE(SK, SV, buf_) do { _Pragma("unroll") for (int i_ = 0; i_ < 2; ++i_) { const int key_ = kkey0 + 16 * i_; \
                *(u32x4*)(lds + ATT_K_OFF + (buf_) * 16384 + key_ * 512 + (kch >> 4) * 256 + (((kch & 15) ^ (key_ & 15)) * 16)) = SK[i_]; \
                *(u32x4*)(lds + ATT_V_OFF + (buf_) * 20480 + (vrow0 + 128 * i_) * 80 + vc4 * 16) = SV[i_]; } } while (0)
            auto tile_body = [&](const int tile, const int buf) __attribute__((always_inline)) {
                f32x16 S;
#pragma unroll
                for (int i = 0; i < 16; ++i) S[i] = 0.f;
                const unsigned char* kb = lds + ATT_K_OFF + buf * 16384 + lr * 512 + g * 256;
#pragma unroll
                for (int kk = 0; kk < 8; ++kk) { const bf16x8 Kf = *(const bf16x8*)(kb + (((2 * kk + hh) ^ (lr & 15)) * 16)); S = __builtin_amdgcn_mfma_f32_32x32x16_bf16(Kf, Qf[kk], S, 0, 0, 0); }
                const unsigned bits2 = bm[lr * 65 + tile] >> (4 * hh);
                float mx = S[0];
#pragma unroll
                for (int i = 1; i < 16; ++i) mx = __builtin_fmaxf(mx, S[i]);
                mx *= 0.12751743f;
                mx = __builtin_fmaxf(mx, __shfl_xor(mx, 32));
                if (__any(mx > m)) { const float mn = __builtin_fmaxf(m, mx), al = __builtin_amdgcn_exp2f(m - mn);
#pragma unroll
                    for (int d = 0; d < 4; ++d)
#pragma unroll
                        for (int i = 0; i < 16; ++i) o[d][i] *= al;
                    l *= al; m = mn; }
                float pr[16];
#pragma unroll
                for (int i = 0; i < 16; ++i) { const int mk = __builtin_amdgcn_sbfe((int)bits2, (i & 3) + 8 * (i >> 2), 1);
                    const float e = __builtin_amdgcn_exp2f(__builtin_fmaf(S[i], 0.12751743f, -m));
                    pr[i] = __int_as_float(__float_as_int(e) & mk); l += pr[i]; }
                bf16x8 Pf[2];
#pragma unroll
                for (int s2 = 0; s2 < 2; ++s2) { u32x4 w; w.x = cvt_pk_bf16(pr[8 * s2 + 0], pr[8 * s2 + 1]); w.y = cvt_pk_bf16(pr[8 * s2 + 2], pr[8 * s2 + 3]);
                    w.z = cvt_pk_bf16(pr[8 * s2 + 4], pr[8 * s2 + 5]); w.w = cvt_pk_bf16(pr[8 * s2 + 6], pr[8 * s2 + 7]); Pf[s2] = __builtin_bit_cast(bf16x8, w); }
                const unsigned char* vb = lds + ATT_V_OFF + buf * 20480 + (g * 128 + lr) * 80 + hh * 16;
#pragma unroll
                for (int d = 0; d < 4; ++d)
#pragma unroll
                    for (int s2 = 0; s2 < 2; ++s2) { const bf16x8 Vf = *(const bf16x8*)(vb + d * 32 * 80 + s2 * 32); o[d] = __builtin_amdgcn_mfma_f32_32x32x16_bf16(Vf, Pf[s2], o[d], 0, 0, 0); }
            };
            ATT_LOAD(sKa, sVa, 0); ATT_STORE(sKa, sVa, 0);
            if (1 < ntiles) ATT_LOAD(sKb, sVb, 1);
            __syncthreads();
            for (int tile = 0; tile < ntiles; tile += 2) {
                if (tile + 2 < ntiles) ATT_LOAD(sKa, sVa, tile + 2);
                tile_body(tile, 0);
                if (tile + 1 < ntiles) ATT_STORE(sKb, sVb, 1);
                __syncthreads();
                if (tile + 1 >= ntiles) break;
                if (tile + 3 < ntiles) ATT_LOAD(sKb, sVb, tile + 3);
                tile_body(tile + 1, 1);
                if (tile + 2 < ntiles) ATT_STORE(sKa, sVa, 0);
                __syncthreads();
            }
#undef ATT_LOAD
#undef ATT_STORE
            l += __shfl_xor(l, 32);
            const float inv = 1.0f / l;
            bf16_t* op = AO + (size_t)(b * SEQ + s0 + lr) * LDX + wave * 128 + 4 * hh;
#pragma unroll
            for (int d = 0; d < 4; ++d)
#pragma unroll
                for (int q4 = 0; q4 < 4; ++q4) { u32x2 w; w.x = cvt_pk_bf16(o[d][4 * q4 + 0] * inv, o[d][4 * q4 + 1] * inv); w.y = cvt_pk_bf16(o[d][4 * q4 + 2] * inv, o[d][4 * q4 + 3] * inv);
                    *(u32x2*)(op + 32 * d + 8 * q4) = w; }
        }
        __syncthreads();
    }
}

#define XB_TMO      128
#define XB_XCNT(j)  (256  + 64 * (j))
#define XB_XSUB(j)  (1280 + 64 * (j))
#define XB_XGEN(j)  (2304 + 64 * (j))
#define XB_TOP      3328
#define XB_TOPGEN   3392
#define XCD_BAR_WORDS 3456
#define XB_SPIN_CAP (1u << 18)
__device__ __forceinline__ unsigned xb_ld(unsigned* p)              { return __hip_atomic_load(p, __ATOMIC_RELAXED, __HIP_MEMORY_SCOPE_AGENT); }
__device__ __forceinline__ unsigned xb_add(unsigned* p, unsigned v) { return __hip_atomic_fetch_add(p, v, __ATOMIC_RELAXED, __HIP_MEMORY_SCOPE_AGENT); }
__device__ __forceinline__ unsigned xb_xcc_id() { return (unsigned)__builtin_amdgcn_s_getreg((3 << 11) | 20) & 0xFu; }
#define XB_SPIN(cond, bar) do { unsigned _sp = 0; while (cond) { __builtin_amdgcn_s_sleep(1); \
    if ((++_sp & 255u) == 0u) { if (xb_ld(&(bar)[XB_TMO])) break; if (_sp > XB_SPIN_CAP) { atomicAdd(&(bar)[XB_TMO], 1u); break; } } } } while (0)
struct XcdBarrier { unsigned* bar; unsigned x; volatile PG8_LAS unsigned* st; };
__device__ __forceinline__ XcdBarrier xcd_barrier_post(unsigned* bar, volatile PG8_LAS unsigned* st) {
    XcdBarrier b; b.bar = bar; b.x = xb_xcc_id(); b.st = st;
    if (threadIdx.x == 0) (void)xb_add(&bar[XB_XCNT(b.x)], 1u);
    return b;
}
__device__ __forceinline__ void xcd_barrier_complete(unsigned* bar, unsigned x, unsigned& nloc, unsigned& nx) {
    const unsigned G = gridDim.x * gridDim.y * gridDim.z;
    unsigned sum, cnt, mine, sp = 0u;
    for (;;) {
        sum = 0u; cnt = 0u; mine = 0u;
#pragma unroll
        for (unsigned j = 0; j < 16; ++j) { const unsigned c = xb_ld(&bar[XB_XCNT(j)]); sum += c; cnt += (c > 0u) ? 1u : 0u; mine = (j == x) ? c : mine; }
        if (sum == G) break;
        __builtin_amdgcn_s_sleep(1);
        if ((++sp & 255u) == 0u) { if (xb_ld(&bar[XB_TMO])) break; if (sp > XB_SPIN_CAP) { atomicAdd(&bar[XB_TMO], 1u); break; } }
    }
    nloc = mine > 0u ? mine : 1u; nx = cnt > 0u ? cnt : 1u;
}
__device__ __forceinline__ void xcd_barrier(const XcdBarrier& b) {
    asm volatile("s_waitcnt vmcnt(0)" ::: "memory");
    __syncthreads();
    if (threadIdx.x == 0) {
        unsigned* bar = b.bar;
        __builtin_amdgcn_s_waitcnt(0);
        unsigned nloc = b.st[0], nx = b.st[1];
        if (nloc == 0u) { xcd_barrier_complete(bar, b.x, nloc, nx); b.st[0] = nloc; b.st[1] = nx; }
        const unsigned old = xb_add(&bar[XB_XSUB(b.x)], 1u);
        const unsigned gen = old / nloc;
        if (old + 1u == (gen + 1u) * nloc) {
            __builtin_amdgcn_fence(__ATOMIC_RELEASE, "agent");
            asm volatile("s_waitcnt vmcnt(0)" ::: "memory");
            const unsigned og = xb_add(&bar[XB_TOP], 1u);
            const unsigned tg = og / nx;
            if (og + 1u == (tg + 1u) * nx) xb_add(&bar[XB_TOPGEN], 1u);
            else XB_SPIN(xb_ld(&bar[XB_TOPGEN]) == tg, bar);
            __builtin_amdgcn_fence(__ATOMIC_ACQUIRE, "agent");
            xb_add(&bar[XB_XGEN(b.x)], 1u);
            asm volatile("s_waitcnt vmcnt(0)" ::: "memory");
        } else {
            XB_SPIN(xb_ld(&bar[XB_XGEN(b.x)]) == gen, bar);
            __builtin_amdgcn_fence(__ATOMIC_ACQUIRE, "agent");
            asm volatile("s_waitcnt vmcnt(0)" ::: "memory");
        }
    }
    __syncthreads();
}
__global__ void __launch_bounds__(512, 2) fwd_megakernel(Params P, int ph_lo, int ph_hi) {
    extern __shared__ __attribute__((aligned(16))) unsigned char lds[];
    cg::grid_group grid = cg::this_grid();
    unsigned char* ws = P.ws;
    PG8_LAS unsigned char* lds3 = (PG8_LAS unsigned char*)lds;
    const int G = gridDim.x, c = blockIdx.x;
    bf16_t* WGU2 = (bf16_t*)(ws + WS_WGU2); bf16_t* WD2 = (bf16_t*)(ws + WS_WD2);
    bf16_t* WGU = (bf16_t*)(ws + WS_WGU); bf16_t* WD = (bf16_t*)(ws + WS_WD); bf16_t* WIN = (bf16_t*)(ws + WS_WIN);
    bf16_t* WA = (bf16_t*)(ws + WS_WA); bf16_t* WC = (bf16_t*)(ws + WS_WC); bf16_t* WO = (bf16_t*)(ws + WS_WO);
    bf16_t* HB = (bf16_t*)(ws + WS_HB); bf16_t* ACT = (bf16_t*)(ws + WS_Z1); bf16_t* Z1 = (bf16_t*)(ws + WS_Z1);
    bf16_t* XCC = (bf16_t*)(ws + WS_XCC); bf16_t* BB = (bf16_t*)(ws + WS_BB); bf16_t* GG = (bf16_t*)(ws + WS_G);
    float* part0 = (float*)(ws + WS_PART); float* part1 = (float*)(ws + WS_PART + PART_SZ); float* part2 = (float*)(ws + WS_PART + 2 * PART_SZ);
    float* hmeta = (float*)(ws + WS_HMETA);
#define IN(k) (ph_lo <= (k) && (k) < ph_hi)
    volatile PG8_LAS unsigned* bst = (volatile PG8_LAS unsigned*)(lds3 + 147456);
    if (threadIdx.x == 0) { bst[0] = 0u; bst[1] = 0u; }
    __syncthreads();
    const XcdBarrier xbar = xcd_barrier_post((unsigned*)(ws + WS_BAR), bst);
    if (ph_hi < 0) grid.sync();
#define SEAM(k) do { if (IN(k) && IN((k) + 1)) xcd_barrier(xbar); } while (0)
    if (IN(0)) phase_prep(P, lds);
    SEAM(0);
    if (IN(1)) { pg8::Gemm g{HB, WGU, MMAIN, 11264, DM, DM, DM}; pg8::StaticOrder S; S.init(MMAIN, 11264, G, c); EpiGU E{ACT, part0, (PG8_LAS float*)(lds3 + 131072), -1}; pg8::gemm_phase(lds3, g, S, E);
        skinny16<true, 8>(HB + (size_t)MMAIN * DM, DM, WGU, DM, 44 * 8, lds, [&](const f32x4& a0, const f32x4& a1, int task, int n0, int r, int kq) {
#pragma unroll
            for (int j = 0; j < 4; ++j) { const int row = kq * 4 + j; const f32x4* pp = (const f32x4*)(part0 + (size_t)(MMAIN + row) * 32); float sm = 0.f;
#pragma unroll
                for (int i = 0; i < 8; ++i) { const f32x4 v = pp[i]; sm += (v[0] + v[1]) + (v[2] + v[3]); }
                const float rs = rsqrtf(sm * (1.0f / 2048.0f) + EPS), gv = a0[j] * rs, uv = a1[j] * rs;
                const float o = gv * sigmoidf_(gv) * uv;
                ACT[(size_t)(MMAIN + row) * DFF + (n0 >> 8) * 128 + (n0 & 127) + r] = (bf16_t)(cvt_pk_bf16(o, 0.f) & 0xffffu); }
        });
    }
    SEAM(1);
    if (IN(2)) { pg8::Gemm g{ACT, WD, MMAIN, 2048, DFF, DFF, DFF}; pg8::StaticOrder S; S.init(MMAIN, 2048, G, c);
        EpiRes E{HB, nullptr, HB, part1, 0.5f}; pg8::gemm_phase(lds3, g, S, E);
        float* partm = (float*)(ws + WS_PARTM);
        skinny16<false, 22>(ACT + (size_t)MMAIN * DFF, DFF, WD, DFF, 128, lds, [&](const f32x4& a0, const f32x4&, int task, int n0, int r, int kq) {
#pragma unroll
            for (int j = 0; j < 4; ++j) { const int row = kq * 4 + j; const float h = P.meta[(size_t)row * DM + n0 + r] + 0.5f * a0[j];
                HB[(size_t)(MMAIN + row) * DM + n0 + r] = (bf16_t)(cvt_pk_bf16(h, 0.f) & 0xffffu);
                float ss = h * h;
                ss += __int_as_float(__builtin_amdgcn_update_dpp(0, __float_as_int(ss), 0xB1, 0xF, 0xF, true));
                ss += __int_as_float(__builtin_amdgcn_update_dpp(0, __float_as_int(ss), 0x4E, 0xF, 0xF, true));
                ss += __int_as_float(__builtin_amdgcn_update_dpp(0, __float_as_int(ss), 0x141, 0xF, 0xF, true));
                ss += __int_as_float(__builtin_amdgcn_update_dpp(0, __float_as_int(ss), 0x140, 0xF, 0xF, true));
                if (r == 0) partm[row * 128 + task] = ss; }
        });
    }
    SEAM(2);
    if (IN(3)) { pg8::Gemm g{HB, WIN, MPAD, NIN, DM, DM, DM}; pg8::StaticOrder S; S.init(MPAD, NIN, G, c); EpiZ E{Z1, XCC, BB, GG, part1, (const float*)(ws + WS_PARTM), (PG8_LAS float*)(lds3 + 131072), -1}; pg8::gemm_phase(lds3, g, S, E); }
    SEAM(3);
    if (IN(4)) phase_post(P, lds);
    SEAM(4);
    if (IN(5)) phase_attn(P, lds);
    SEAM(5);
    if (IN(6)) { pg8::Gemm g{XCC, WA, MMAIN, 2048, 1024, LDX, 1024}; pg8::StaticOrder S; S.init(MMAIN, 2048, G, c); EpiGate E{GG, 0}; pg8::gemm_phase(lds3, g, S, E); }
    if (IN(7)) { pg8::Gemm g{BB, WC, MMAIN, 2048, 1024, LDX, 1024}; pg8::StaticOrder S; S.init(MMAIN, 2048, G, c); EpiGate E{GG, 1}; pg8::gemm_phase(lds3, g, S, E); }
    SEAM(7);
    if (IN(8)) { pg8::Gemm g{GG, WO, MMAIN, 2048, DM, LDG, DM}; pg8::StaticOrder S; S.init(MMAIN, 2048, G, c);
        EpiRes E{HB, nullptr, HB, part2, 1.0f}; pg8::gemm_phase(lds3, g, S, E); }
    SEAM(8);
    if (IN(9)) { pg8::Gemm g{HB, WGU2, MMAIN, 11264, DM, DM, DM}; pg8::StaticOrder S; S.init(MMAIN, 11264, G, c); EpiGU E{ACT, part2, (PG8_LAS float*)(lds3 + 131072), -1}; pg8::gemm_phase(lds3, g, S, E); }
    SEAM(9);
    if (IN(10)) { pg8::Gemm g{ACT, WD2, MMAIN, 2048, DFF, DFF, DFF}; pg8::StaticOrder S; S.init(MMAIN, 2048, G, c);
        EpiRes E{HB, P.out, nullptr, nullptr, 0.5f}; pg8::gemm_phase(lds3, g, S, E); }
#undef IN
#undef SEAM
}

extern "C" void kernel_launch(void* const* d_in, const int* in_sizes, int n_in, void* d_out, int out_size, void* d_ws, size_t ws_size, hipStream_t stream) {
    static int grid = 0;
    if (grid == 0) {
        if (n_in != 19 || ws_size < WS_END) { fprintf(stderr, "kernel_launch: unexpected n_in %d / ws_size %zu (need %zu)\n", n_in, ws_size, (size_t)WS_END); grid = -1; return; }
        int dev = 0, cus = 0, per_cu = 0;
        hipGetDevice(&dev); hipDeviceGetAttribute(&cus, hipDeviceAttributeMultiprocessorCount, dev);
        if (hipFuncSetAttribute((const void*)fwd_megakernel, hipFuncAttributeMaxDynamicSharedMemorySize, LDS_BYTES) != hipSuccess) { fprintf(stderr, "kernel_launch: hipFuncSetAttribute failed\n"); grid = -1; return; }
        if (hipOccupancyMaxActiveBlocksPerMultiprocessor(&per_cu, (const void*)fwd_megakernel, 512, LDS_BYTES) != hipSuccess || per_cu < 1) { fprintf(stderr, "kernel_launch: occupancy query says %d\n", per_cu); per_cu = 1; }
        (void)hipGetLastError();
        grid = cus;
    }
    if (grid < 0) return;
    if (hipMemsetAsync((char*)d_ws + WS_BAR, 0, 16384, stream) != hipSuccess) { fprintf(stderr, "kernel_launch: memset failed\n"); return; }
    Params p{};
    p.x = (const float*)d_in[0]; p.meta = (const float*)d_in[1]; p.g1 = (const float*)d_in[2]; p.wg1 = (const float*)d_in[3]; p.wu1 = (const float*)d_in[4]; p.wd1 = (const float*)d_in[5];
    p.gm = (const float*)d_in[6]; p.win = (const float*)d_in[7]; p.qg = (const float*)d_in[8]; p.kg = (const float*)d_in[9]; p.cw = (const float*)d_in[10]; p.cbias = (const float*)d_in[11];
    p.wa = (const float*)d_in[12]; p.wc = (const float*)d_in[13]; p.wo = (const float*)d_in[14]; p.g2 = (const float*)d_in[15]; p.wg2 = (const float*)d_in[16]; p.wu2 = (const float*)d_in[17]; p.wd2 = (const float*)d_in[18];
    p.out = (float*)d_out; p.ws = (unsigned char*)d_ws;
    int lo = 0, hi = 11;
    void* args[] = {&p, &lo, &hi};
    hipError_t e = hipLaunchCooperativeKernel((const void*)fwd_megakernel, dim3(grid), dim3(512), args, LDS_BYTES, stream);
    if (e != hipSuccess) fprintf(stderr, "cooperative launch failed: %s (grid %d)\n", hipGetErrorString(e), grid);
}
```

```cpp
#include <hip/hip_runtime.h>
#include <hip/hip_cooperative_groups.h>
#include <cstdio>
namespace cg = cooperative_groups;

typedef unsigned short bf16_t;
typedef short bf16x8 __attribute__((ext_vector_type(8)));
typedef float f32x4 __attribute__((ext_vector_type(4)));
typedef float f32x16 __attribute__((ext_vector_type(16)));
typedef unsigned u32x4 __attribute__((ext_vector_type(4)));
typedef unsigned u32x2 __attribute__((ext_vector_type(2)));

constexpr int DM = 2048, NBATCH = 8, SEQ = 2048, NMETA = 16, TT = 2064, DFF = 5632;
constexpr int MMAIN = 16384, MPAD = 16640;
constexpr int LDZ = 2816, LDX = 1024, LDG = 4096;
constexpr int NIN = 9984;
constexpr int TPAD = 2080;
constexpr float EPS = 1e-6f;
constexpr int LDS_BYTES = 147472;

constexpr size_t WS_WGU = 0;
constexpr size_t WS_WD = WS_WGU + (size_t)11264 * 2048 * 2;
constexpr size_t WS_XCC = WS_WGU;
constexpr size_t WS_BB = WS_XCC + (size_t)MPAD * LDX * 2;
constexpr size_t WS_WGU2 = WS_WD + (size_t)2048 * 5632 * 2;
constexpr size_t WS_WD2 = WS_WGU2 + (size_t)11264 * 2048 * 2;
constexpr size_t WS_WIN = WS_WD2 + (size_t)2048 * 5632 * 2;
constexpr size_t WS_WA = WS_WIN + (size_t)NIN * 2048 * 2;
constexpr size_t WS_WC = WS_WA + (size_t)2048 * 1024 * 2;
constexpr size_t WS_WO = WS_WC + (size_t)2048 * 1024 * 2;
constexpr size_t WS_HB = WS_WO + (size_t)2048 * 2048 * 2;
constexpr size_t WS_Z1 = WS_HB + (size_t)MPAD * 2048 * 2;
constexpr size_t WS_G = WS_Z1 + (size_t)MPAD * LDZ * 2;
constexpr size_t WS_VT = WS_G + (size_t)MPAD * LDG * 2;
constexpr size_t WS_PART = WS_VT + (size_t)NBATCH * 2 * 128 * TPAD * 2;
constexpr size_t PART_SZ = (size_t)MPAD * 32 * 4;
constexpr size_t WS_HMETA = WS_PART + 3 * PART_SZ;
constexpr size_t WS_ROPE = WS_HMETA + (size_t)256 * 2048 * 4;
constexpr size_t WS_PARTM = WS_ROPE + (size_t)TT * 48 * 4;
constexpr size_t WS_BAR = WS_PARTM + 16 * 128 * 4;
constexpr size_t WS_KI2 = WS_BAR + 16384;
constexpr size_t WS_END = WS_KI2 + (size_t)NBATCH * 65 * 4096;
static_assert(WS_Z1 + (size_t)MPAD * DFF * 2 <= WS_VT, "act alias");
static_assert(WS_BB + (size_t)MPAD * LDX * 2 <= WS_WGU2, "xcc/bb alias");
static_assert(WS_END <= (size_t)536870912, "workspace");

__device__ __forceinline__ unsigned cvt_pk_bf16(float lo, float hi) { unsigned r; asm volatile("v_cvt_pk_bf16_f32 %0, %1, %2" : "=v"(r) : "v"(lo), "v"(hi)); return r; }
__device__ __forceinline__ float bf_lo(unsigned w) { return __uint_as_float(w << 16); }
__device__ __forceinline__ float bf_hi(unsigned w) { return __uint_as_float(w & 0xffff0000u); }
__device__ __forceinline__ float bf2f(bf16_t b) { return __uint_as_float(((unsigned)b) << 16); }
__device__ __forceinline__ float sigmoidf_(float x) { return __builtin_amdgcn_rcpf(1.0f + __expf(-x)); }
__device__ __forceinline__ void unpack8(const u32x4 w, float (&f)[8]) {
    f[0] = bf_lo(w.x); f[1] = bf_hi(w.x); f[2] = bf_lo(w.y); f[3] = bf_hi(w.y); f[4] = bf_lo(w.z); f[5] = bf_hi(w.z); f[6] = bf_lo(w.w); f[7] = bf_hi(w.w); }
__device__ __forceinline__ u32x4 pack8(const float (&f)[8]) { u32x4 w; w.x = cvt_pk_bf16(f[0], f[1]); w.y = cvt_pk_bf16(f[2], f[3]); w.z = cvt_pk_bf16(f[4], f[5]); w.w = cvt_pk_bf16(f[6], f[7]); return w; }
__device__ __forceinline__ void rstd8(const float* part, int row0, int fq, float (&rs)[8]) {
    f32x4 v[8][2];
#pragma unroll
    for (int k = 0; k < 8; ++k) { const f32x4* p = (const f32x4*)(part + (size_t)(row0 + (k >> 2) * 128 + (k & 3) * 16) * 32 + fq * 8); v[k][0] = p[0]; v[k][1] = p[1]; }
#pragma unroll
    for (int k = 0; k < 8; ++k) { float s = ((v[k][0][0] + v[k][0][1]) + (v[k][0][2] + v[k][0][3])) + ((v[k][1][0] + v[k][1][1]) + (v[k][1][2] + v[k][1][3]));
        s += __shfl_xor(s, 16); s += __shfl_xor(s, 32); rs[k] = rsqrtf(s * (1.0f / 2048.0f) + EPS); }
}

namespace pg8 {
#define PG8_LAS __attribute__((address_space(3)))
constexpr int BM = 256, BK = 64, HALF = 128, HTB = HALF * BK * 2, STAGE_BYTES = 8 * HTB, NXCD = 8, WGM = 8;
__host__ __device__ __forceinline__ int lds_byte(int r, int c) { const int st = (r >> 4) * 2 + (c >> 5), rr = r & 15, cc = c & 31, ob = rr * 64 + cc * 2; return st * 1024 + (ob ^ (((ob >> 9) & 1) << 5)); }
__host__ __device__ __forceinline__ void stage_rc(int b, int& R, int& C) { const int st = b / 1024, sb = b % 1024, swz = sb ^ (((sb >> 9) & 1) << 5); R = (st >> 1) * 16 + swz / 64; C = (st & 1) * 32 + (swz % 64) / 2; }
__host__ __device__ __forceinline__ int perm32(int rho) { const int n = rho >> 4, i = rho & 15; return 8 * (i >> 2) + 4 * n + (i & 3); }
struct Unit { int pm, pn; };
struct Gemm { const bf16_t* A; const bf16_t* Bt; int M, N, K, lda, ldb; };
struct StaticOrder {
    int nM, nN, nwg, G, c;
    __device__ void init(int M, int N, int G_, int c_) { nM = M / BM; nN = N / BM; nwg = nM * nN; G = G_; c = c_; }
    __device__ bool next(int i, Unit& u) const {
        const long L = (long)i * G + c; if (L >= nwg) return false;
        int wgid = (int)L; { const int q = nwg / NXCD, r = nwg % NXCD, xcd = wgid % NXCD, off = wgid / NXCD; wgid = (xcd < r ? xcd * (q + 1) : r * (q + 1) + (xcd - r) * q) + off; }
        const int nig = WGM * nN, gid = wgid / nig, fm = gid * WGM, gsz = (nM - fm) < WGM ? (nM - fm) : WGM;
        u.pm = fm + ((wgid % nig) % gsz); u.pn = (wgid % nig) / gsz; return true;
    }
};

template <class Epi>
__device__ __forceinline__ void gemm_phase(PG8_LAS unsigned char* lds, const Gemm g, const StaticOrder& S, const Epi& E) {
    const int tid = threadIdx.x, wid = __builtin_amdgcn_readfirstlane(tid >> 6), lane = tid & 63, wr = wid >> 2, wc = wid & 3, fr = lane & 15, fq = lane >> 4;
    const int K = g.K, nt = K / BK;
    unsigned voffA[2], voffB[2];
#pragma unroll
    for (int i = 0; i < 2; ++i) { int R, C; stage_rc(tid * 16 + i * 8192, R, C); const int Rb = Epi::PERM ? ((R & ~31) + perm32(R & 31)) : R;
        voffA[i] = (unsigned)(R * g.lda + C) * 2u; voffB[i] = (unsigned)(Rb * g.ldb + C) * 2u; }
    const size_t kstep = (size_t)(BK * 2);
    const size_t hstepA = (size_t)HALF * g.lda * 2, hstepB = (size_t)HALF * g.ldb * 2;
    const size_t tstepA = 2 * hstepA, tstepB = 2 * hstepB;
    const unsigned ldsw = (unsigned)wid * 1024u;
    const int aoff = lds_byte(wr * 64 + fr, fq * 8), boff = lds_byte(wc * 32 + fr, fq * 8);
#define PG8_SA(b, h) (((b) * 2 + (h)) * HTB)
#define PG8_SB(b, h) ((4 + (b) * 2 + (h)) * HTB)
#define PG8_STAGE(bufoff, gbase, voff) do { _Pragma("unroll") for (int _i = 0; _i < 2; ++_i) \
        __builtin_amdgcn_global_load_lds((const unsigned*)((const char*)(gbase) + (voff)[_i]), (PG8_LAS unsigned*)(lds + (bufoff) + ldsw + _i * 8192), 16, 0, 0); } while (0)
#define PG8_LDA(dst, b, h) do { _Pragma("unroll") for (int m = 0; m < 4; ++m) _Pragma("unroll") for (int k = 0; k < 2; ++k) dst[m][k] = *(const PG8_LAS bf16x8*)(lds + PG8_SA(b, h) + aoff + m * 2048 + k * 1024); } while (0)
#define PG8_LDB(dst, b, h) do { _Pragma("unroll") for (int n = 0; n < 2; ++n) _Pragma("unroll") for (int k = 0; k < 2; ++k) dst[n][k] = *(const PG8_LAS bf16x8*)(lds + PG8_SB(b, h) + boff + n * 2048 + k * 1024); } while (0)
#define PG8_MMA(ai, bj, At, Bt) do { __builtin_amdgcn_s_setprio(1); _Pragma("unroll") for (int m = 0; m < 4; ++m) _Pragma("unroll") for (int n = 0; n < 2; ++n) _Pragma("unroll") for (int k = 0; k < 2; ++k) \
        acc[ai][bj][m][n] = __builtin_amdgcn_mfma_f32_16x16x32_bf16(Bt[n][k], At[m][k], acc[ai][bj][m][n], 0, 0, 0); __builtin_amdgcn_s_setprio(0); } while (0)
#define PG8_WAIT_V(n) asm volatile("s_waitcnt vmcnt(" #n ")" ::: "memory")
#define PG8_WAIT_L(n) asm volatile("s_waitcnt lgkmcnt(" #n ")" ::: "memory")
#define PG8_BAR __builtin_amdgcn_s_barrier()
#define PG8_SCHED __builtin_amdgcn_sched_barrier(0)
    Unit cur, nxt; int ui = 0;
    if (!S.next(0, cur)) return;
    f32x4 acc[2][2][4][2];
#pragma unroll
    for (int a = 0; a < 2; ++a)
#pragma unroll
        for (int b = 0; b < 2; ++b)
#pragma unroll
            for (int m = 0; m < 4; ++m)
#pragma unroll
                for (int n = 0; n < 2; ++n) acc[a][b][m][n] = (f32x4){0.f, 0.f, 0.f, 0.f};
    bf16x8 At[4][2], B0[2][2], B1[2][2];
    const char* cA = (const char*)g.A + (size_t)cur.pm * tstepA; const char* cB = (const char*)g.Bt + (size_t)cur.pn * tstepB;
    PG8_STAGE(PG8_SB(0, 0), cB, voffB); PG8_STAGE(PG8_SA(0, 0), cA, voffA); PG8_STAGE(PG8_SB(0, 1), cB + hstepB, voffB); PG8_STAGE(PG8_SA(0, 1), cA + hstepA, voffA);
    if (wr == 1) PG8_BAR;
    PG8_WAIT_V(4); PG8_BAR;
    PG8_STAGE(PG8_SB(1, 0), cB + kstep, voffB); PG8_STAGE(PG8_SA(1, 0), cA + kstep, voffA); PG8_STAGE(PG8_SB(1, 1), cB + hstepB + kstep, voffB);
    PG8_WAIT_V(6); PG8_BAR;
    for (;;) {
        const bool has_next = S.next(ui + 1, nxt);
        const char* nA = has_next ? (const char*)g.A + (size_t)nxt.pm * tstepA : cA; const char* nB = has_next ? (const char*)g.Bt + (size_t)nxt.pn * tstepB : cB;
        for (int t = 0; t < nt; t += 2) {
            const bool last = (t == nt - 2);
            const char* a1 = cA + (size_t)(t + 1) * kstep;
            const char* a2 = last ? nA : cA + (size_t)(t + 2) * kstep; const char* b2 = last ? nB : cB + (size_t)(t + 2) * kstep;
            const char* a3 = a2 + kstep; const char* b3 = b2 + kstep;
            PG8_LDB(B0, 0, 0); PG8_SCHED; PG8_LDA(At, 0, 0); PG8_STAGE(PG8_SA(1, 1), a1 + hstepA, voffA);
            PG8_WAIT_L(8); PG8_BAR; PG8_WAIT_L(0); PG8_MMA(0, 0, At, B0); PG8_BAR; PG8_SCHED;
            PG8_LDB(B1, 0, 1); PG8_STAGE(PG8_SB(0, 0), b2, voffB);
            PG8_BAR; PG8_WAIT_L(0); PG8_MMA(0, 1, At, B1); PG8_BAR;
            PG8_LDA(At, 0, 1); PG8_STAGE(PG8_SA(0, 0), a2, voffA);
            PG8_BAR; PG8_WAIT_L(0); PG8_MMA(1, 0, At, B0); PG8_BAR; PG8_SCHED;
            PG8_STAGE(PG8_SB(0, 1), b2 + hstepB, voffB);
            PG8_WAIT_V(6); PG8_BAR; PG8_MMA(1, 1, At, B1); PG8_BAR;
            PG8_LDB(B0, 1, 0); PG8_SCHED; PG8_LDA(At, 1, 0); PG8_STAGE(PG8_SA(0, 1), a2 + hstepA, voffA);
            PG8_WAIT_L(8); PG8_BAR; PG8_WAIT_L(0); PG8_MMA(0, 0, At, B0); PG8_BAR; PG8_SCHED;
            PG8_LDB(B1, 1, 1); PG8_STAGE(PG8_SB(1, 0), b3, voffB);
            PG8_BAR; PG8_WAIT_L(0); PG8_MMA(0, 1, At, B1); PG8_BAR;
            PG8_LDA(At, 1, 1); PG8_STAGE(PG8_SA(1, 0), a3, voffA);
            PG8_BAR; PG8_WAIT_L(0); PG8_MMA(1, 0, At, B0); PG8_BAR; PG8_SCHED;
            PG8_STAGE(PG8_SB(1, 1), b3 + hstepB, voffB);
            PG8_WAIT_V(6); PG8_BAR; PG8_MMA(1, 1, At, B1); PG8_BAR;
        }
        E(acc, cur, wr, wc, fr, fq);
        if (!has_next) break;
#pragma unroll
        for (int a = 0; a < 2; ++a)
#pragma unroll
            for (int b = 0; b < 2; ++b)
#pragma unroll
                for (int m = 0; m < 4; ++m)
#pragma unroll
                    for (int n = 0; n < 2; ++n) acc[a][b][m][n] = (f32x4){0.f, 0.f, 0.f, 0.f};
        cur = nxt; cA = nA; cB = nB; ++ui;
    }
    PG8_WAIT_V(0);
    if (wr == 0) PG8_BAR;
    PG8_BAR;
#undef PG8_SA
#undef PG8_SB
#undef PG8_STAGE
#undef PG8_LDA
#undef PG8_LDB
#undef PG8_MMA
#undef PG8_WAIT_V
#undef PG8_WAIT_L
#undef PG8_BAR
#undef PG8_SCHED
}
}

struct EpiGU {
    static constexpr bool PERM = true;
    bf16_t* act; const float* part; PG8_LAS float* rs_lds; mutable int cached_pm;
    __device__ __forceinline__ void operator()(const f32x4 (&acc)[2][2][4][2], const pg8::Unit& u, int wr, int wc, int fr, int fq) const {
        const int row0 = u.pm * 256 + wr * 64 + fr, col0 = u.pn * 128 + wc * 32 + 8 * fq;
        float rsv[8]; PG8_LAS float* mine = rs_lds + (wr * 4 + wc) * 512 + fq * 16 + fr;
        if (u.pm != cached_pm) { rstd8(part, row0, fq, rsv);
#pragma unroll
            for (int k = 0; k < 8; ++k) mine[k * 64] = rsv[k];
            cached_pm = u.pm; }
        else {
#pragma unroll
            for (int k = 0; k < 8; ++k) rsv[k] = mine[k * 64]; }
#pragma unroll
        for (int ai = 0; ai < 2; ++ai)
#pragma unroll
            for (int m = 0; m < 4; ++m) {
                const int r = row0 + ai * 128 + m * 16; const float rs = rsv[ai * 4 + m];
                float o[8];
#pragma unroll
                for (int n = 0; n < 2; ++n)
#pragma unroll
                    for (int i = 0; i < 4; ++i) { const float gv = acc[ai][0][m][n][i] * rs, uv = acc[ai][1][m][n][i] * rs; o[n * 4 + i] = gv * sigmoidf_(gv) * uv; }
                *(u32x4*)(act + (size_t)r * DFF + col0) = pack8(o);
            }
    }
};
struct EpiRes {
    static constexpr bool PERM = true;
    const bf16_t* resb; float* outf; bf16_t* hb; float* part; float coef;
    __device__ __forceinline__ void operator()(const f32x4 (&acc)[2][2][4][2], const pg8::Unit& u, int wr, int wc, int fr, int fq) const {
        const int row0 = u.pm * 256 + wr * 64 + fr, col0 = u.pn * 256 + wc * 32 + 8 * fq;
#pragma unroll
        for (int ai = 0; ai < 2; ++ai) {
            u32x4 rb[4][2];
#pragma unroll
            for (int m = 0; m < 4; ++m)
#pragma unroll
                for (int bj = 0; bj < 2; ++bj) rb[m][bj] = *(const u32x4*)(resb + (size_t)(row0 + ai * 128 + m * 16) * DM + col0 + bj * 128);
#pragma unroll
            for (int m = 0; m < 4; ++m) {
                const int r = row0 + ai * 128 + m * 16; float ss = 0.f;
#pragma unroll
                for (int bj = 0; bj < 2; ++bj) {
                    const size_t off = (size_t)r * DM + col0 + bj * 128;
                    float rv[8], o[8]; unpack8(rb[m][bj], rv);
#pragma unroll
                    for (int n = 0; n < 2; ++n)
#pragma unroll
                        for (int i = 0; i < 4; ++i) o[n * 4 + i] = rv[n * 4 + i] + coef * acc[ai][bj][m][n][i];
                    if (outf) { *(f32x4*)(outf + off) = (f32x4){o[0], o[1], o[2], o[3]}; *(f32x4*)(outf + off + 4) = (f32x4){o[4], o[5], o[6], o[7]}; }
                    if (hb) { *(u32x4*)(hb + off) = pack8(o);
#pragma unroll
                        for (int i = 0; i < 8; ++i) ss += o[i] * o[i]; }
                }
                if (hb) { ss += __shfl_xor(ss, 16); ss += __shfl_xor(ss, 32); if (fq == 0) part[(size_t)r * 32 + u.pn * 4 + wc] = ss; }
            }
        }
    }
};
struct EpiZ {
    static constexpr bool PERM = true;
    bf16_t* Z1; bf16_t* XCC; bf16_t* BB; bf16_t* G; const float* part; const float* partm; PG8_LAS float* rs_lds; mutable int cached_pm;
    __device__ __forceinline__ void operator()(const f32x4 (&acc)[2][2][4][2], const pg8::Unit& u, int wr, int wc, int fr, int fq) const {
        const int row0 = u.pm * 256 + wr * 64 + fr; const int pn = u.pn;
        bf16_t* base; int ld, cb; const bool paired = (pn >= 11 && pn < 19);
        if (pn < 11) { base = Z1; ld = LDZ; cb = pn * 256; } else if (pn < 19) { base = XCC; ld = LDX; cb = (pn - 11) * 128; } else if (pn < 23) { base = BB; ld = LDX; cb = (pn - 19) * 256; } else { base = G; ld = LDG; cb = (pn - 23) * 256; }
        cb += wc * 32 + 8 * fq;
        float rsv[8]; PG8_LAS float* mine = rs_lds + (wr * 4 + wc) * 512 + fq * 16 + fr;
        if (u.pm < 64 && u.pm == cached_pm) {
#pragma unroll
            for (int k = 0; k < 8; ++k) rsv[k] = mine[k * 64]; }
        else if (u.pm < 64) { rstd8(part, row0, fq, rsv);
#pragma unroll
            for (int k = 0; k < 8; ++k) mine[k * 64] = rsv[k];
            cached_pm = u.pm; }
        else {
#pragma unroll
            for (int k = 0; k < 8; ++k) rsv[k] = 0.f;
            const f32x4* pp = (const f32x4*)(partm + fr * 128 + fq * 32); float sm = 0.f;
#pragma unroll
            for (int i = 0; i < 8; ++i) { const f32x4 v = pp[i]; sm += (v[0] + v[1]) + (v[2] + v[3]); }
            sm += __shfl_xor(sm, 16); sm += __shfl_xor(sm, 32);
            if (wr == 0) rsv[0] = rsqrtf(sm * (1.0f / 2048.0f) + EPS);
        }
#pragma unroll
        for (int ai = 0; ai < 2; ++ai)
#pragma unroll
            for (int m = 0; m < 4; ++m) {
                const int r = row0 + ai * 128 + m * 16; const float rs = rsv[ai * 4 + m];
                bf16_t* rowp = base + (size_t)r * ld + cb;
                if (paired) {
                    float o[8]; const float rs2 = rs * rs;
#pragma unroll
                    for (int n = 0; n < 2; ++n)
#pragma unroll
                        for (int i = 0; i < 4; ++i) o[n * 4 + i] = acc[ai][0][m][n][i] * acc[ai][1][m][n][i] * rs2;
                    *(u32x4*)rowp = pack8(o);
                } else {
#pragma unroll
                    for (int bj = 0; bj < 2; ++bj) { float o[8];
#pragma unroll
                        for (int n = 0; n < 2; ++n)
#pragma unroll
                            for (int i = 0; i < 4; ++i) o[n * 4 + i] = acc[ai][bj][m][n][i] * rs;
                        *(u32x4*)(rowp + bj * 128) = pack8(o); }
                }
            }
    }
};
struct EpiGate {
    static constexpr bool PERM = true;
    bf16_t* G; int mode;
    __device__ __forceinline__ void operator()(const f32x4 (&acc)[2][2][4][2], const pg8::Unit& u, int wr, int wc, int fr, int fq) const {
        const int row0 = u.pm * 256 + wr * 64 + fr, col0 = u.pn * 256 + wc * 32 + 8 * fq;
#pragma unroll
        for (int ai = 0; ai < 2; ++ai) {
            u32x4 la[4][2], lg[4][2];
#pragma unroll
            for (int m = 0; m < 4; ++m)
#pragma unroll
                for (int bj = 0; bj < 2; ++bj) { const bf16_t* p = G + (size_t)(row0 + ai * 128 + m * 16) * LDG + col0 + bj * 128;
                    la[m][bj] = *(const u32x4*)p; if (mode != 0) lg[m][bj] = *(const u32x4*)(p + 2048); else lg[m][bj] = la[m][bj]; }
#pragma unroll
            for (int m = 0; m < 4; ++m)
#pragma unroll
                for (int bj = 0; bj < 2; ++bj) {
                    bf16_t* p = G + (size_t)(row0 + ai * 128 + m * 16) * LDG + col0 + bj * 128;
                    float a[8], gt[8], o[8];
                    unpack8(la[m][bj], a);
                    if (mode == 0) {
#pragma unroll
                        for (int n = 0; n < 2; ++n)
#pragma unroll
                            for (int i = 0; i < 4; ++i) o[n * 4 + i] = sigmoidf_(a[n * 4 + i]) * acc[ai][bj][m][n][i];
                    } else {
                        unpack8(lg[m][bj], gt);
#pragma unroll
                        for (int n = 0; n < 2; ++n)
#pragma unroll
                            for (int i = 0; i < 4; ++i) o[n * 4 + i] = a[n * 4 + i] + sigmoidf_(gt[n * 4 + i]) * acc[ai][bj][m][n][i];
                    }
                    *(u32x4*)p = pack8(o);
                }
        }
    }
};

template <bool PAIR, int STEPS, class F>
__device__ __forceinline__ void skinny16(const bf16_t* A, int lda, const bf16_t* Bt, int K, int ntasks, unsigned char* lds, F&& epi) {
    const int lane = threadIdx.x & 63, wv_ = threadIdx.x >> 6, r = lane & 15, kq = lane >> 4;
    f32x4* red = (f32x4*)lds;
    for (int task = blockIdx.x; task < ntasks; task += gridDim.x) {
        int n0, n1;
        if (PAIR) { n0 = (task >> 3) * 256 + (task & 7) * 16; n1 = n0 + 128; } else { n0 = task * 16; n1 = n0; }
        const int kbeg = wv_ * STEPS * 32;
        const bf16_t* ap = A + (size_t)r * lda + kbeg + kq * 8;
        const bf16_t* b0 = Bt + (size_t)(n0 + r) * K + kbeg + kq * 8;
        const bf16_t* b1 = Bt + (size_t)(n1 + r) * K + kbeg + kq * 8;
        f32x4 acc0 = {0.f, 0.f, 0.f, 0.f}, acc1 = {0.f, 0.f, 0.f, 0.f};
#pragma unroll
        for (int st = 0; st < STEPS; ++st) {
            const bf16x8 a = *(const bf16x8*)(ap + st * 32), x0 = *(const bf16x8*)(b0 + st * 32);
            acc0 = __builtin_amdgcn_mfma_f32_16x16x32_bf16(a, x0, acc0, 0, 0, 0);
            if (PAIR) { const bf16x8 x1 = *(const bf16x8*)(b1 + st * 32); acc1 = __builtin_amdgcn_mfma_f32_16x16x32_bf16(a, x1, acc1, 0, 0, 0); }
        }
        red[(wv_ * 2 + 0) * 64 + lane] = acc0; if (PAIR) red[(wv_ * 2 + 1) * 64 + lane] = acc1;
        __syncthreads();
        if (wv_ == 0) {
            f32x4 s0 = red[lane], s1 = {0.f, 0.f, 0.f, 0.f}; if (PAIR) s1 = red[64 + lane];
#pragma unroll
            for (int w = 1; w < 8; ++w) { s0 += red[(w * 2) * 64 + lane]; if (PAIR) s1 += red[(w * 2 + 1) * 64 + lane]; }
            epi(s0, s1, task, n0, r, kq);
        }
        __syncthreads();
    }
}

struct ConvJob { const float* W0; const float* W1; const float* g; bf16_t* dst; int ldw, K, N, mode; };
__device__ __forceinline__ void convert_unit(const ConvJob& J, int u, int lane) {
    const int nkb = J.K / 32;
    {
        const int ch = u / nkb, kb = u % nkb;
        const int n = ch * 256 + lane * 4; const float* src = J.W0; int col = n;
        if (J.mode == 1) { col = (n >> 8) * 128 + (n & 127); if ((n >> 7) & 1) src = J.W1; }
        else if (J.mode == 2) { const int pn = n >> 8;
            if (pn < 11) col = (n < 2640) ? n : -1;
            else if (pn < 19) col = (((n >> 7) & 1) ? 4688 : 2640) + (pn - 11) * 128 + (n & 127);
            else if (pn < 23) col = 3664 + (n - 19 * 256);
            else col = 5712 + (n - 23 * 256); }
        const float* sp = src + (size_t)(kb * 32) * J.ldw + (col >= 0 ? col : 0);
        f32x4 v[4][8];
#pragma unroll
        for (int it = 0; it < 4; ++it)
#pragma unroll
            for (int i = 0; i < 8; ++i) v[it][i] = __builtin_nontemporal_load((const f32x4*)(sp + (size_t)(it * 8 + i) * J.ldw));
        if (col < 0) {
#pragma unroll
            for (int it = 0; it < 4; ++it)
#pragma unroll
                for (int i = 0; i < 8; ++i) v[it][i] = (f32x4){0.f, 0.f, 0.f, 0.f}; }
        if (J.g) {
#pragma unroll
            for (int it = 0; it < 4; ++it)
#pragma unroll
                for (int i = 0; i < 8; ++i) v[it][i] *= J.g[kb * 32 + it * 8 + i]; }
        bf16_t* dp = J.dst + (size_t)n * J.K + kb * 32;
#pragma unroll
        for (int jn = 0; jn < 4; ++jn)
#pragma unroll
            for (int it = 0; it < 4; ++it) { u32x4 w; w.x = cvt_pk_bf16(v[it][0][jn], v[it][1][jn]); w.y = cvt_pk_bf16(v[it][2][jn], v[it][3][jn]); w.z = cvt_pk_bf16(v[it][4][jn], v[it][5][jn]); w.w = cvt_pk_bf16(v[it][6][jn], v[it][7][jn]);
                *(u32x4*)(dp + (size_t)jn * J.K + it * 8) = w; }
    }
}

struct Params {
    const float* x; const float* meta; const float* g1; const float* wg1; const float* wu1; const float* wd1;
    const float* gm; const float* win; const float* qg; const float* kg; const float* cw; const float* cbias;
    const float* wa; const float* wc; const float* wo; const float* g2; const float* wg2; const float* wu2; const float* wd2;
    float* out; unsigned char* ws;
};

__device__ __forceinline__ int key_row(int b, int t) { return t < NMETA ? MMAIN + t : b * SEQ + t - NMETA; }

__device__ __forceinline__ void sincos_d(double a, float& s_out, float& c_out) {
    const double TWO_PI = 6.283185307179586476925286766559, INV = 0.15915494309189533576888376337251;
    const double n = rint(a * INV); double r = a - n * TWO_PI;
    const double y = 0.5 * r, y2 = y * y;
    double s = 1.0, c = 1.0, ts = 1.0, tc = 1.0;
#pragma unroll
    for (int k = 1; k <= 12; ++k) { tc *= -y2 / (double)((2 * k - 1) * (2 * k)); ts *= -y2 / (double)((2 * k) * (2 * k + 1)); c += tc; s += ts; }
    s *= y;
    s_out = (float)(2.0 * s * c); c_out = (float)(1.0 - 2.0 * s * s);
}

__device__ __forceinline__ void phase_prep(const Params& P, unsigned char* lds) {
    unsigned char* ws = P.ws;
    const int tid = threadIdx.x, lane = tid & 63, wave = tid >> 6;
    { float* rope = (float*)(ws + WS_ROPE);
      for (int idx = blockIdx.x * 512 + tid; idx < TT * 24; idx += gridDim.x * 512) {
          const int t = idx / 24, f = idx % 24; float inv;
          if (f < 16) inv = (float)exp2(-((double)(2 * f) / 32.0) * 18.931568569324174);
          else inv = (float)exp2(-((double)(2 * (f - 16)) / 16.0) * 18.931568569324174);
          const float ang = (float)t * inv; float s, c; sincos_d((double)ang, s, c);
          if (f < 16) { rope[t * 48 + f] = c; rope[t * 48 + 16 + f] = s; } else { rope[t * 48 + 32 + (f - 16)] = c; rope[t * 48 + 40 + (f - 16)] = s; }
      } }
    { bf16_t* HB = (bf16_t*)(ws + WS_HB); float* part = (float*)(ws + WS_PART); float* hmeta = (float*)(ws + WS_HMETA);
      auto row_src = [&](int r) -> const float* { return r < MMAIN ? P.x + (size_t)r * DM : (r < MMAIN + NMETA ? P.meta + (size_t)(r - MMAIN) * DM : nullptr); };
      auto row_out = [&](int r, const f32x4 (&v)[8]) __attribute__((always_inline)) {
          float ss = 0.f;
#pragma unroll
          for (int i = 0; i < 8; ++i) { const int c = i * 256 + lane * 4;
              ss += (v[i][0] * v[i][0] + v[i][1] * v[i][1]) + (v[i][2] * v[i][2] + v[i][3] * v[i][3]);
              u32x2 w; w.x = cvt_pk_bf16(v[i][0], v[i][1]); w.y = cvt_pk_bf16(v[i][2], v[i][3]); *(u32x2*)(HB + (size_t)r * DM + c) = w;
              if (r >= MMAIN) *(f32x4*)(hmeta + (size_t)(r - MMAIN) * DM + c) = v[i]; }
#pragma unroll
          for (int o = 32; o >= 1; o >>= 1) ss += __shfl_xor(ss, o);
          if (lane < 32) part[(size_t)r * 32 + lane] = (lane == 0) ? ss : 0.f;
      };
      const int rstride = gridDim.x * 8;
      for (int r0 = blockIdx.x * 8 + wave; r0 < MPAD; r0 += 2 * rstride) {
          const int r1 = r0 + rstride; const bool has1 = r1 < MPAD;
          const float* s0 = row_src(r0); const float* s1 = has1 ? row_src(r1) : nullptr;
          f32x4 va[8], vb[8];
#pragma unroll
          for (int i = 0; i < 8; ++i) va[i] = s0 ? __builtin_nontemporal_load((const f32x4*)(s0 + i * 256 + lane * 4)) : (f32x4){0.f, 0.f, 0.f, 0.f};
#pragma unroll
          for (int i = 0; i < 8; ++i) vb[i] = s1 ? __builtin_nontemporal_load((const f32x4*)(s1 + i * 256 + lane * 4)) : (f32x4){0.f, 0.f, 0.f, 0.f};
          row_out(r0, va);
          if (has1) row_out(r1, vb);
      } }
    {
        unsigned char* w = ws;
        const int lane_ = tid & 63, gw = blockIdx.x * 8 + wave, nw = gridDim.x * 8;
        constexpr int U0 = 44 * 64, U1 = U0 + 8 * 176, U2 = U1 + 44 * 64, U3 = U2 + 8 * 176, U4 = U3 + 39 * 64, U5 = U4 + 8 * 32, U6 = U5 + 8 * 32, U7 = U6 + 8 * 64;
        for (int u = gw; u < U7; u += nw) {
            if (u < U0)      { ConvJob J{P.wg1, P.wu1, P.g1, (bf16_t*)(w + WS_WGU), DFF, DM, 11264, 1}; convert_unit(J, u, lane_); }
            else if (u < U1) { ConvJob J{P.wd1, nullptr, nullptr, (bf16_t*)(w + WS_WD), DM, DFF, 2048, 0}; convert_unit(J, u - U0, lane_); }
            else if (u < U2) { ConvJob J{P.wg2, P.wu2, P.g2, (bf16_t*)(w + WS_WGU2), DFF, DM, 11264, 1}; convert_unit(J, u - U1, lane_); }
            else if (u < U3) { ConvJob J{P.wd2, nullptr, nullptr, (bf16_t*)(w + WS_WD2), DM, DFF, 2048, 0}; convert_unit(J, u - U2, lane_); }
            else if (u < U4) { ConvJob J{P.win, nullptr, P.gm, (bf16_t*)(w + WS_WIN), 9808, DM, NIN, 2}; convert_unit(J, u - U3, lane_); }
            else if (u < U5) { ConvJob J{P.wa, nullptr, nullptr, (bf16_t*)(w + WS_WA), DM, 1024, 2048, 0}; convert_unit(J, u - U4, lane_); }
            else if (u < U6) { ConvJob J{P.wc, nullptr, nullptr, (bf16_t*)(w + WS_WC), DM, 1024, 2048, 0}; convert_unit(J, u - U5, lane_); }
            else             { ConvJob J{P.wo, nullptr, nullptr, (bf16_t*)(w + WS_WO), DM, DM, 2048, 0}; convert_unit(J, u - U6, lane_); }
        }
    }
}

__device__ __forceinline__ void norm_rope16(u32x4& w0, u32x4& w1, const f32x4 (&gn)[4], const f32x4 (&cs)[8], int part) {
    float v[16];
    { float a[8], b[8]; unpack8(w0, a); unpack8(w1, b);
#pragma unroll
      for (int i = 0; i < 8; ++i) { v[i] = a[i]; v[8 + i] = b[i]; } }
    float ss = 0.f;
#pragma unroll
    for (int i = 0; i < 16; ++i) ss += v[i] * v[i];
    ss += __shfl_xor(ss, 1); ss += __shfl_xor(ss, 2); ss += __shfl_xor(ss, 4);
    const float rs = rsqrtf(ss * (1.0f / 128.0f) + EPS);
    float y[16];
#pragma unroll
    for (int i = 0; i < 16; ++i) y[i] = v[i] * rs * gn[i >> 2][i & 3];
#pragma unroll
    for (int i = 0; i < 16; ++i) { const float other = __shfl_xor(y[i], 1);
        if (part < 2) { const float c = cs[i >> 2][i & 3], sn = cs[4 + (i >> 2)][i & 3];
            y[i] = (part == 0) ? (y[i] * c - other * sn) : (y[i] * c + other * sn); } }
    { float a[8], b[8];
#pragma unroll
      for (int i = 0; i < 8; ++i) { a[i] = y[i]; b[i] = y[8 + i]; }
      w0 = pack8(a); w1 = pack8(b); }
}
__device__ __forceinline__ void rope_idx16(u32x4& w0, u32x4& w1, const f32x4 (&ci)[4]  ) {
    float a[8], b[8]; unpack8(w0, a); unpack8(w1, b);
    float r1[8], r2[8];
#pragma unroll
    for (int i = 0; i < 8; ++i) { const float c = ci[i >> 2][i & 3], sn = ci[2 + (i >> 2)][i & 3]; r1[i] = a[i] * c - b[i] * sn; r2[i] = b[i] * c + a[i] * sn; }
    w0 = pack8(r1); w1 = pack8(r2);
}
__device__ __forceinline__ void phase_post(const Params& P, unsigned char* lds) {
    unsigned char* ws = P.ws;
    bf16_t* Z1 = (bf16_t*)(ws + WS_Z1); bf16_t* XCC = (bf16_t*)(ws + WS_XCC); bf16_t* BB = (bf16_t*)(ws + WS_BB); bf16_t* HB = (bf16_t*)(ws + WS_HB);
    bf16_t* VT = (bf16_t*)(ws + WS_VT); const float* rope = (const float*)(ws + WS_ROPE);
    const int tid = threadIdx.x, lane = tid & 63, wave = tid >> 6;
    bf16_t* vt_l = (bf16_t*)lds;
    float* tq = (float*)(lds + 16384); float* tk = tq + 128; float* tcw = tk + 128; float* tcb = tcw + 3072;
    for (int i = tid; i < 128 + 128 + 3072 + 1024; i += 512) tq[i] = i < 128 ? P.qg[i] : (i < 256 ? P.kg[i - 128] : (i < 3328 ? P.cw[i - 256] : P.cbias[i - 3328]));
    __syncthreads();
    for (int blk = blockIdx.x; blk < 513; blk += gridDim.x) {
        const bool mblk = (blk == 512);
        const int b = blk >> 6, j = blk & 63;
        const int nrows = mblk ? 16 : 32, rbase = mblk ? MMAIN : b * SEQ + j * 32, t0 = mblk ? 0 : j * 32 + NMETA;
        for (int rl = wave; rl < nrows; rl += 8) {
            const int r = rbase + rl, t = t0 + rl; const float* rt = rope + (size_t)t * 48;
            bf16_t* zr = Z1 + (size_t)r * LDZ;
            bf16_t* qp = zr + 16 * lane; bf16_t* kp = zr + 1024 + 16 * (lane & 15); bf16_t* ip = zr + 1536 + 16 * lane; bf16_t* jp = zr + 2560 + 16 * (lane & 3);
            u32x4 q0 = *(const u32x4*)qp, q1 = *(const u32x4*)(qp + 8), k0 = *(const u32x4*)kp, k1 = *(const u32x4*)(kp + 8);
            u32x4 i0 = *(const u32x4*)ip, i1 = *(const u32x4*)(ip + 8), j0 = *(const u32x4*)jp, j1 = *(const u32x4*)(jp + 8);
            const u32x4 vv = *(const u32x4*)(zr + 1280 + (lane & 31) * 8);
            f32x4 cs[8], ci[4];
#pragma unroll
            for (int i = 0; i < 8; ++i) cs[i] = *(const f32x4*)(rt + 4 * i);
#pragma unroll
            for (int i = 0; i < 4; ++i) ci[i] = *(const f32x4*)(rt + 32 + 4 * i);
            if (!mblk) {
                const int c = lane * 16;
                const int sidx = r & (SEQ - 1);
                const int r1 = sidx >= 1 ? r - 1 : MMAIN + 15, r2 = sidx >= 2 ? r - 2 : MMAIN + 14 + sidx;
                u32x4 x0[2], x1[2], x2[2], bv[2]; f32x4 cw0[4], cw1[4], cw2[4], cb[4];
#pragma unroll
                for (int hq = 0; hq < 2; ++hq) { x0[hq] = *(const u32x4*)(XCC + (size_t)r * LDX + c + hq * 8); x1[hq] = *(const u32x4*)(XCC + (size_t)r1 * LDX + c + hq * 8);
                    x2[hq] = *(const u32x4*)(XCC + (size_t)r2 * LDX + c + hq * 8); bv[hq] = *(const u32x4*)(BB + (size_t)r * LDX + c + hq * 8); }
#pragma unroll
                for (int i = 0; i < 4; ++i) { cw0[i] = *(const f32x4*)(tcw + c + 4 * i); cw1[i] = *(const f32x4*)(tcw + 1024 + c + 4 * i); cw2[i] = *(const f32x4*)(tcw + 2048 + c + 4 * i); cb[i] = *(const f32x4*)(tcb + c + 4 * i); }
#pragma unroll
                for (int hq = 0; hq < 2; ++hq) { float a0[8], a1[8], a2[8], ab[8], o[8];
                    unpack8(x0[hq], a0); unpack8(x1[hq], a1); unpack8(x2[hq], a2); unpack8(bv[hq], ab);
#pragma unroll
                    for (int i = 0; i < 8; ++i) { const int q4 = hq * 2 + (i >> 2), e = i & 3;
                        const float y = cw0[q4][e] * a2[i] + cw1[q4][e] * a1[i] + cw2[q4][e] * a0[i] + cb[q4][e]; o[i] = ab[i] * y; }
                    *(u32x4*)(BB + (size_t)r * LDX + c + hq * 8) = pack8(o); }
            }
            f32x4 gq[4], gk[4];
#pragma unroll
            for (int i = 0; i < 4; ++i) { gq[i] = *(const f32x4*)(tq + (lane & 7) * 16 + 4 * i); gk[i] = *(const f32x4*)(tk + (lane & 7) * 16 + 4 * i); }
            norm_rope16(q0, q1, gq, cs, lane & 7);
            norm_rope16(k0, k1, gk, cs, lane & 7);
            rope_idx16(i0, i1, ci);
            const u32x4 j0raw = j0, j1raw = j1;
            rope_idx16(j0, j1, ci);
            *(u32x4*)qp = q0; *(u32x4*)(qp + 8) = q1;
            if (lane < 16) { *(u32x4*)kp = k0; *(u32x4*)(kp + 8) = k1; }
            if ((lane & 3) == 0) { *(u32x4*)ip = i0; *(u32x4*)(ip + 8) = i1; }
            if (lane == 0) { *(u32x4*)jp = j0; *(u32x4*)(jp + 8) = j1; }
            if (lane < 4) {
                const int half = lane >> 1, kk0 = 2 * (lane & 1);
                const int bb0 = mblk ? 0 : b, bb1 = mblk ? NBATCH : b + 1;
                for (int bb = bb0; bb < bb1; ++bb) {
                    unsigned char* kt = ws + WS_KI2 + ((size_t)bb * 65 + (t >> 5)) * 4096 + (half * 32 + (t & 31)) * 16;
                    *(u32x4*)(kt + kk0 * 1024) = (lane == 0) ? j0 : j0raw; *(u32x4*)(kt + (kk0 + 1) * 1024) = (lane == 0) ? j1 : j1raw; }
            }
            if (lane < 32) *(u32x4*)(vt_l + rl * 256 + lane * 8) = vv;
        }
        __syncthreads();
        { const int gd = tid >> 1, half = tid & 1;
          if (half * 16 < nrows) {
              unsigned w[8];
#pragma unroll
              for (int pp = 0; pp < 8; ++pp) { unsigned lo, hi;
                  { const int p0 = 2 * pp, kk = 8 * ((p0 >> 2) & 1) + 4 * (p0 >> 3) + (p0 & 3); lo = vt_l[(half * 16 + kk) * 256 + gd]; }
                  { const int p1 = 2 * pp + 1, kk = 8 * ((p1 >> 2) & 1) + 4 * (p1 >> 3) + (p1 & 3); hi = vt_l[(half * 16 + kk) * 256 + gd]; }
                  w[pp] = lo | (hi << 16); }
              u32x4 w0 = {w[0], w[1], w[2], w[3]}, w1 = {w[4], w[5], w[6], w[7]};
              const int bb0 = mblk ? 0 : b, bb1 = mblk ? NBATCH : b + 1;
              const int tpos = t0 + half * 16;
              for (int bb = bb0; bb < bb1; ++bb) { bf16_t* d = VT + (((size_t)bb * 65 + (tpos >> 5)) * 256 + gd) * 32 + (tpos & 31); *(u32x4*)d = w0; *(u32x4*)(d + 8) = w1; }
          }
          if (!mblk && j == 63 && half == 0) { bf16_t* d = VT + (((size_t)b * 65 + 64) * 256 + gd) * 32 + 16; u32x4 z = {0u, 0u, 0u, 0u}; *(u32x4*)d = z; *(u32x4*)(d + 8) = z; }
        }
        __syncthreads();
    }
}

__device__ __forceinline__ unsigned ordered_key(float f) { const unsigned u = __float_as_uint(f); return u ^ ((u >> 31) ? 0xffffffffu : 0x80000000u); }
constexpr int ATT_SC_OFF = 0, ATT_BM_OFF = 133120, ATT_K_OFF = 0, ATT_V_OFF = 32768;
__device__ __forceinline__ void phase_attn(const Params& P, unsigned char* lds) {
    unsigned char* ws = P.ws;
    const bf16_t* Z1 = (const bf16_t*)(ws + WS_Z1); const bf16_t* VT = (const bf16_t*)(ws + WS_VT); bf16_t* AO = (bf16_t*)(ws + WS_XCC);
    const int tid = threadIdx.x, lane = tid & 63, wave = tid >> 6, lr = lane & 31, hh = lane >> 5;
    unsigned* scU = (unsigned*)(lds + ATT_SC_OFF); unsigned* bm = (unsigned*)(lds + ATT_BM_OFF);
    for (int idx = blockIdx.x; idx < 512; idx += gridDim.x) {
        const int b = idx & 7; const int j = idx < 256 ? 63 - (idx >> 3) : ((idx - 256) >> 3);
        const int s0 = j * 32, ntiles = j + 2;
        for (int pp = 0; pp < 2; ++pp) {
            const int p = wave * 2 + pp; const int sq = s0 + 2 * p + hh; const int rowq = b * SEQ + sq;
            bf16x8 Aq[4];
            { const int qa = s0 + 2 * p + ((lr >> 2) & 1), ha = (lr & 3) + 4 * (lr >> 3);
              const bf16_t* ap = Z1 + (size_t)(b * SEQ + qa) * LDZ + 1536 + ha * 64 + hh * 32;
#pragma unroll
              for (int kk = 0; kk < 4; ++kk) Aq[kk] = *(const bf16x8*)(ap + kk * 8); }
            float wv[16];
            { float a[8], c[8]; unpack8(*(const u32x4*)(Z1 + (size_t)rowq * LDZ + 2624), a); unpack8(*(const u32x4*)(Z1 + (size_t)rowq * LDZ + 2632), c);
#pragma unroll
              for (int i = 0; i < 8; ++i) { wv[i] = a[i]; wv[8 + i] = c[i]; } }
            unsigned* myrow = scU + (wave * 2 + hh) * TPAD + lr;
            bf16x8 B0[4], B1[4], B2[4], B3[4];
#define IDX_LOAD(BUF, tl) do { const int tc_ = (tl) < 64 ? (tl) : 64; const unsigned char* bp_ = ws + WS_KI2 + ((size_t)b * 65 + tc_) * 4096 + (hh * 32 + lr) * 16; \
                _Pragma("unroll") for (int kk = 0; kk < 4; ++kk) BUF[kk] = *(const bf16x8*)(bp_ + kk * 1024); } while (0)
#define IDX_TILE(BUF, tl) do { const int t_ = (tl) * 32 + lr; f32x16 acc_; \
                _Pragma("unroll") for (int i = 0; i < 16; ++i) acc_[i] = 0.f; \
                _Pragma("unroll") for (int kk = 0; kk < 4; ++kk) acc_ = __builtin_amdgcn_mfma_f32_32x32x16_bf16(Aq[kk], BUF[kk], acc_, 0, 0, 0); \
                IDX_LOAD(BUF, (tl) + 4); \
                float sc_ = 0.f, sd_ = 0.f; \
                _Pragma("unroll") for (int i = 0; i < 16; i += 2) { sc_ += wv[i] * __int_as_float(max(__float_as_int(acc_[i]), 0)); sd_ += wv[i + 1] * __int_as_float(max(__float_as_int(acc_[i + 1]), 0)); } \
                sc_ += sd_; \
                myrow[(tl) * 32] = (t_ <= sq + NMETA) ? ordered_key(sc_) : 0u; } while (0)
            IDX_LOAD(B0, 0); IDX_LOAD(B1, 1); IDX_LOAD(B2, 2); IDX_LOAD(B3, 3);
            for (int tile = 0; tile < ntiles; tile += 4) {
                IDX_TILE(B0, tile);
                if (tile + 1 < ntiles) IDX_TILE(B1, tile + 1);
                if (tile + 2 < ntiles) IDX_TILE(B2, tile + 2);
                if (tile + 3 < ntiles) IDX_TILE(B3, tile + 3);
            }
#undef IDX_LOAD
#undef IDX_TILE
            const int nch = (ntiles + 7) >> 3;
            for (int tile = ntiles; tile < nch * 8 && tile < 65; ++tile) myrow[tile * 32] = 0u;
            unsigned key[72];
#pragma unroll
            for (int ch = 0; ch < 9; ++ch) {
                if (ch < nch) {
#pragma unroll
                    for (int jj = 0; jj < 8; ++jj) { const int jx = ch * 8 + jj; key[jx] = (jx < 65) ? myrow[jx * 32] : 0u; }
                } else {
#pragma unroll
                    for (int jj = 0; jj < 8; ++jj) key[ch * 8 + jj] = 0u;
                }
            }
            unsigned prefix = 0u;
            for (int bit = 31; bit >= 8; --bit) {
                const unsigned cand = prefix | (1u << bit); const int c31 = (int)(cand >> 1);
                int lt0 = 0, lt1 = 0;
#pragma unroll
                for (int ch = 0; ch < 9; ++ch) {
                    if (ch < nch) {
#pragma unroll
                        for (int jj = 0; jj < 8; jj += 2) { lt0 += (int)((unsigned)((int)(key[ch * 8 + jj] >> 1) - c31) >> 31); lt1 += (int)((unsigned)((int)(key[ch * 8 + jj + 1] >> 1) - c31) >> 31); }
                    }
                }
                int cnt = nch * 8 - (lt0 + lt1);
                cnt += __builtin_amdgcn_update_dpp(0, cnt, 0xB1, 0xF, 0xF, true);
                cnt += __builtin_amdgcn_update_dpp(0, cnt, 0x4E, 0xF, 0xF, true);
                cnt += __builtin_amdgcn_update_dpp(0, cnt, 0x141, 0xF, 0xF, true);
                cnt += __builtin_amdgcn_update_dpp(0, cnt, 0x140, 0xF, 0xF, true);
                cnt += __shfl_xor(cnt, 16);
                if (cnt >= 256) prefix = cand;
            }
            const unsigned thr = prefix > 1u ? prefix : 1u;
#pragma unroll
            for (int ch = 0; ch < 9; ++ch) {
                if (ch < nch) {
#pragma unroll
                    for (int jj = 0; jj < 8; ++jj) { const int jx = ch * 8 + jj;
                        if (jx < 65) { const unsigned long long bal = __ballot(key[jx] >= thr);
                            const unsigned word = hh ? (unsigned)(bal >> 32) : (unsigned)bal;
                            if (lr == 0) bm[(2 * p + hh) * 65 + jx] = word; } }
                }
            }
        }
        __syncthreads();
        {
            const int g = wave >> 2;
            bf16x8 Qf[8];
            { const bf16_t* qp = Z1 + (size_t)(b * SEQ + s0 + lr) * LDZ + wave * 128 + hh * 8;
#pragma unroll
              for (int kk = 0; kk < 8; ++kk) Qf[kk] = *(const bf16x8*)(qp + kk * 16); }
#pragma unroll
            for (int kk = 0; kk < 8; ++kk) asm volatile("" :: "v"(Qf[kk]));
            f32x16 o[4];
#pragma unroll
            for (int d = 0; d < 4; ++d)
#pragma unroll
                for (int i = 0; i < 16; ++i) o[d][i] = 0.f;
            float m = -1e30f, l = 0.f;
            const int kkey0 = tid >> 5, kch = tid & 31;
            const int vrow0 = tid >> 2, vc4 = tid & 3;
            u32x4 sKa[2], sVa[2], sKb[2], sVb[2];
#define ATT_LOAD(SK, SV, tile_) do { _Pragma("unroll") for (int i_ = 0; i_ < 2; ++i_) { const int key_ = kkey0 + 16 * i_; int t_ = (tile_) * 32 + key_; t_ = t_ < TT ? t_ : TT - 1; \
                SK[i_] = *(const u32x4*)(Z1 + (size_t)key_row(b, t_) * LDZ + 1024 + kch * 8); \
                SV[i_] = *(const u32x4*)(VT + (((size_t)b * 65 + (tile_)) * 256 + vrow0 + 128 * i_) * 32 + vc4 * 8); } } while (0)
#define ATT_STORE(SK, SV, buf_) do { _Pragma("unroll") for (int i_ = 0; i_ < 2; ++i_) { const int key_ = kkey0 + 16 * i_; \
                *(u32x4*)(lds + ATT_K_OFF + (buf_) * 16384 + key_ * 512 + (kch >> 4) * 256 + (((kch & 15) ^ (key_ & 15)) * 16)) = SK[i_]; \
                *(u32x4*)(lds + ATT_V_OFF + (buf_) * 20480 + (vrow0 + 128 * i_) * 80 + vc4 * 16) = SV[i_]; } } while (0)
            auto tile_body = [&](const int tile, const int buf) __attribute__((always_inline)) {
                f32x16 S;
#pragma unroll
                for (int i = 0; i < 16; ++i) S[i] = 0.f;
                const unsigned char* kb = lds + ATT_K_OFF + buf * 16384 + lr * 512 + g * 256;
#pragma unroll
                for (int kk = 0; kk < 8; ++kk) { const bf16x8 Kf = *(const bf16x8*)(kb + (((2 * kk + hh) ^ (lr & 15)) * 16)); S = __builtin_amdgcn_mfma_f32_32x32x16_bf16(Kf, Qf[kk], S, 0, 0, 0); }
                const unsigned bits2 = bm[lr * 65 + tile] >> (4 * hh);
                float mx = S[0];
#pragma unroll
                for (int i = 1; i < 16; ++i) mx = __builtin_fmaxf(mx, S[i]);
                mx *= 0.12751743f;
                mx = __builtin_fmaxf(mx, __shfl_xor(mx, 32));
                if (__any(mx > m)) { const float mn = __builtin_fmaxf(m, mx), al = __builtin_amdgcn_exp2f(m - mn);
#pragma unroll
                    for (int d = 0; d < 4; ++d)
#pragma unroll
                        for (int i = 0; i < 16; ++i) o[d][i] *= al;
                    l *= al; m = mn; }
                float pr[16];
#pragma unroll
                for (int i = 0; i < 16; ++i) { const int mk = __builtin_amdgcn_sbfe((int)bits2, (i & 3) + 8 * (i >> 2), 1);
                    const float e = __builtin_amdgcn_exp2f(__builtin_fmaf(S[i], 0.12751743f, -m));
                    pr[i] = __int_as_float(__float_as_int(e) & mk); l += pr[i]; }
                bf16x8 Pf[2];
#pragma unroll
                for (int s2 = 0; s2 < 2; ++s2) { u32x4 w; w.x = cvt_pk_bf16(pr[8 * s2 + 0], pr[8 * s2 + 1]); w.y = cvt_pk_bf16(pr[8 * s2 + 2], pr[8 * s2 + 3]);
                    w.z = cvt_pk_bf16(pr[8 * s2 + 4], pr[8 * s2 + 5]); w.w = cvt_pk_bf16(pr[8 * s2 + 6], pr[8 * s2 + 7]); Pf[s2] = __builtin_bit_cast(bf16x8, w); }
                const unsigned char* vb = lds + ATT_V_OFF + buf * 20480 + (g * 128 + lr) * 80 + hh * 16;
#pragma unroll
                for (int d = 0; d < 4; ++d)
#pragma unroll
                    for (int s2 = 0; s2 < 2; ++s2) { const bf16x8 Vf = *(const bf16x8*)(vb + d * 32 * 80 + s2 * 32); o[d] = __builtin_amdgcn_mfma_f32_32x32x16_bf16(Vf, Pf[s2], o[d], 0, 0, 0); }
            };
            ATT_LOAD(sKa, sVa, 0); ATT_STORE(sKa, sVa, 0);
            if (1 < ntiles) ATT_LOAD(sKb, sVb, 1);
            __syncthreads();
            for (int tile = 0; tile < ntiles; tile += 2) {
                if (tile + 2 < ntiles) ATT_LOAD(sKa, sVa, tile + 2);
                tile_body(tile, 0);
                if (tile + 1 < ntiles) ATT_STORE(sKb, sVb, 1);
                __syncthreads();
                if (tile + 1 >= ntiles) break;
                if (tile + 3 < ntiles) ATT_LOAD(sKb, sVb, tile + 3);
                tile_body(tile + 1, 1);
                if (tile + 2 < ntiles) ATT_STORE(sKa, sVa, 0);
                __syncthreads();
            }
#undef ATT_LOAD
#undef ATT_STORE
            l += __shfl_xor(l, 32);
            const float inv = 1.0f / l;
            bf16_t* op = AO + (size_t)(b * SEQ + s0 + lr) * LDX + wave * 128 + 4 * hh;
#pragma unroll
            for (int d = 0; d < 4; ++d)
#pragma unroll
                for (int q4 = 0; q4 < 4; ++q4) { u32x2 w; w.x = cvt_pk_bf16(o[d][4 * q4 + 0] * inv, o[d][4 * q4 + 1] * inv); w.y = cvt_pk_bf16(o[d][4 * q4 + 2] * inv, o[d][4 * q4 + 3] * inv);
                    *(u32x2*)(op + 32 * d + 8 * q4) = w; }
        }
        __syncthreads();
    }
}

#define XB_TMO      128
#define XB_XCNT(j)  (256  + 64 * (j))
#define XB_XSUB(j)  (1280 + 64 * (j))
#define XB_XGEN(j)  (2304 + 64 * (j))
#define XB_TOP      3328
#define XB_TOPGEN   3392
#define XCD_BAR_WORDS 3456
#define XB_SPIN_CAP (1u << 18)
__device__ __forceinline__ unsigned xb_ld(unsigned* p)              { return __hip_atomic_load(p, __ATOMIC_RELAXED, __HIP_MEMORY_SCOPE_AGENT); }
__device__ __forceinline__ unsigned xb_add(unsigned* p, unsigned v) { return __hip_atomic_fetch_add(p, v, __ATOMIC_RELAXED, __HIP_MEMORY_SCOPE_AGENT); }
__device__ __forceinline__ unsigned xb_xcc_id() { return (unsigned)__builtin_amdgcn_s_getreg((3 << 11) | 20) & 0xFu; }
#define XB_SPIN(cond, bar) do { unsigned _sp = 0; while (cond) { __builtin_amdgcn_s_sleep(1); \
    if ((++_sp & 255u) == 0u) { if (xb_ld(&(bar)[XB_TMO])) break; if (_sp > XB_SPIN_CAP) { atomicAdd(&(bar)[XB_TMO], 1u); break; } } } } while (0)
struct XcdBarrier { unsigned* bar; unsigned x; volatile PG8_LAS unsigned* st; };
__device__ __forceinline__ XcdBarrier xcd_barrier_post(unsigned* bar, volatile PG8_LAS unsigned* st) {
    XcdBarrier b; b.bar = bar; b.x = xb_xcc_id(); b.st = st;
    if (threadIdx.x == 0) (void)xb_add(&bar[XB_XCNT(b.x)], 1u);
    return b;
}
__device__ __forceinline__ void xcd_barrier_complete(unsigned* bar, unsigned x, unsigned& nloc, unsigned& nx) {
    const unsigned G = gridDim.x * gridDim.y * gridDim.z;
    unsigned sum, cnt, mine, sp = 0u;
    for (;;) {
        sum = 0u; cnt = 0u; mine = 0u;
#pragma unroll
        for (unsigned j = 0; j < 16; ++j) { const unsigned c = xb_ld(&bar[XB_XCNT(j)]); sum += c; cnt += (c > 0u) ? 1u : 0u; mine = (j == x) ? c : mine; }
        if (sum == G) break;
        __builtin_amdgcn_s_sleep(1);
        if ((++sp & 255u) == 0u) { if (xb_ld(&bar[XB_TMO])) break; if (sp > XB_SPIN_CAP) { atomicAdd(&bar[XB_TMO], 1u); break; } }
    }
    nloc = mine > 0u ? mine : 1u; nx = cnt > 0u ? cnt : 1u;
}
__device__ __forceinline__ void xcd_barrier(const XcdBarrier& b) {
    asm volatile("s_waitcnt vmcnt(0)" ::: "memory");
    __syncthreads();
    if (threadIdx.x == 0) {
        unsigned* bar = b.bar;
        __builtin_amdgcn_s_waitcnt(0);
        unsigned nloc = b.st[0], nx = b.st[1];
        if (nloc == 0u) { xcd_barrier_complete(bar, b.x, nloc, nx); b.st[0] = nloc; b.st[1] = nx; }
        const unsigned old = xb_add(&bar[XB_XSUB(b.x)], 1u);
        const unsigned gen = old / nloc;
        if (old + 1u == (gen + 1u) * nloc) {
            __builtin_amdgcn_fence(__ATOMIC_RELEASE, "agent");
            asm volatile("s_waitcnt vmcnt(0)" ::: "memory");
            const unsigned og = xb_add(&bar[XB_TOP], 1u);
            const unsigned tg = og / nx;
            if (og + 1u == (tg + 1u) * nx) xb_add(&bar[XB_TOPGEN], 1u);
            else XB_SPIN(xb_ld(&bar[XB_TOPGEN]) == tg, bar);
            __builtin_amdgcn_fence(__ATOMIC_ACQUIRE, "agent");
            xb_add(&bar[XB_XGEN(b.x)], 1u);
            asm volatile("s_waitcnt vmcnt(0)" ::: "memory");
        } else {
            XB_SPIN(xb_ld(&bar[XB_XGEN(b.x)]) == gen, bar);
            __builtin_amdgcn_fence(__ATOMIC_ACQUIRE, "agent");
            asm volatile("s_waitcnt vmcnt(0)" ::: "memory");
        }
    }
    __syncthreads();
}
__global__ void __launch_bounds__(512, 2) fwd_megakernel(Params P, int ph_lo, int ph_hi) {
    extern __shared__ __attribute__((aligned(16))) unsigned char lds[];
    cg::grid_group grid = cg::this_grid();
    unsigned char* ws = P.ws;
    PG8_LAS unsigned char* lds3 = (PG8_LAS unsigned char*)lds;
    const int G = gridDim.x, c = blockIdx.x;
    bf16_t* WGU2 = (bf16_t*)(ws + WS_WGU2); bf16_t* WD2 = (bf16_t*)(ws + WS_WD2);
    bf16_t* WGU = (bf16_t*)(ws + WS_WGU); bf16_t* WD = (bf16_t*)(ws + WS_WD); bf16_t* WIN = (bf16_t*)(ws + WS_WIN);
    bf16_t* WA = (bf16_t*)(ws + WS_WA); bf16_t* WC = (bf16_t*)(ws + WS_WC); bf16_t* WO = (bf16_t*)(ws + WS_WO);
    bf16_t* HB = (bf16_t*)(ws + WS_HB); bf16_t* ACT = (bf16_t*)(ws + WS_Z1); bf16_t* Z1 = (bf16_t*)(ws + WS_Z1);
    bf16_t* XCC = (bf16_t*)(ws + WS_XCC); bf16_t* BB = (bf16_t*)(ws + WS_BB); bf16_t* GG = (bf16_t*)(ws + WS_G);
    float* part0 = (float*)(ws + WS_PART); float* part1 = (float*)(ws + WS_PART + PART_SZ); float* part2 = (float*)(ws + WS_PART + 2 * PART_SZ);
    float* hmeta = (float*)(ws + WS_HMETA);
#define IN(k) (ph_lo <= (k) && (k) < ph_hi)
    volatile PG8_LAS unsigned* bst = (volatile PG8_LAS unsigned*)(lds3 + 147456);
    if (threadIdx.x == 0) { bst[0] = 0u; bst[1] = 0u; }
    __syncthreads();
    const XcdBarrier xbar = xcd_barrier_post((unsigned*)(ws + WS_BAR), bst);
    if (ph_hi < 0) grid.sync();
#define SEAM(k) do { if (IN(k) && IN((k) + 1)) xcd_barrier(xbar); } while (0)
    if (IN(0)) phase_prep(P, lds);
    SEAM(0);
    if (IN(1)) { pg8::Gemm g{HB, WGU, MMAIN, 11264, DM, DM, DM}; pg8::StaticOrder S; S.init(MMAIN, 11264, G, c); EpiGU E{ACT, part0, (PG8_LAS float*)(lds3 + 131072), -1}; pg8::gemm_phase(lds3, g, S, E);
        skinny16<true, 8>(HB + (size_t)MMAIN * DM, DM, WGU, DM, 44 * 8, lds, [&](const f32x4& a0, const f32x4& a1, int task, int n0, int r, int kq) {
#pragma unroll
            for (int j = 0; j < 4; ++j) { const int row = kq * 4 + j; const f32x4* pp = (const f32x4*)(part0 + (size_t)(MMAIN + row) * 32); float sm = 0.f;
#pragma unroll
                for (int i = 0; i < 8; ++i) { const f32x4 v = pp[i]; sm += (v[0] + v[1]) + (v[2] + v[3]); }
                const float rs = rsqrtf(sm * (1.0f / 2048.0f) + EPS), gv = a0[j] * rs, uv = a1[j] * rs;
                const float o = gv * sigmoidf_(gv) * uv;
                ACT[(size_t)(MMAIN + row) * DFF + (n0 >> 8) * 128 + (n0 & 127) + r] = (bf16_t)(cvt_pk_bf16(o, 0.f) & 0xffffu); }
        });
    }
    SEAM(1);
    if (IN(2)) { pg8::Gemm g{ACT, WD, MMAIN, 2048, DFF, DFF, DFF}; pg8::StaticOrder S; S.init(MMAIN, 2048, G, c);
        EpiRes E{HB, nullptr, HB, part1, 0.5f}; pg8::gemm_phase(lds3, g, S, E);
        float* partm = (float*)(ws + WS_PARTM);
        skinny16<false, 22>(ACT + (size_t)MMAIN * DFF, DFF, WD, DFF, 128, lds, [&](const f32x4& a0, const f32x4&, int task, int n0, int r, int kq) {
#pragma unroll
            for (int j = 0; j < 4; ++j) { const int row = kq * 4 + j; const float h = P.meta[(size_t)row * DM + n0 + r] + 0.5f * a0[j];
                HB[(size_t)(MMAIN + row) * DM + n0 + r] = (bf16_t)(cvt_pk_bf16(h, 0.f) & 0xffffu);
                float ss = h * h;
                ss += __int_as_float(__builtin_amdgcn_update_dpp(0, __float_as_int(ss), 0xB1, 0xF, 0xF, true));
                ss += __int_as_float(__builtin_amdgcn_update_dpp(0, __float_as_int(ss), 0x4E, 0xF, 0xF, true));
                ss += __int_as_float(__builtin_amdgcn_update_dpp(0, __float_as_int(ss), 0x141, 0xF, 0xF, true));
                ss += __int_as_float(__builtin_amdgcn_update_dpp(0, __float_as_int(ss), 0x140, 0xF, 0xF, true));
                if (r == 0) partm[row * 128 + task] = ss; }
        });
    }
    SEAM(2);
    if (IN(3)) { pg8::Gemm g{HB, WIN, MPAD, NIN, DM, DM, DM}; pg8::StaticOrder S; S.init(MPAD, NIN, G, c); EpiZ E{Z1, XCC, BB, GG, part1, (const float*)(ws + WS_PARTM), (PG8_LAS float*)(lds3 + 131072), -1}; pg8::gemm_phase(lds3, g, S, E); }
    SEAM(3);
    if (IN(4)) phase_post(P, lds);
    SEAM(4);
    if (IN(5)) phase_attn(P, lds);
    SEAM(5);
    if (IN(6)) { pg8::Gemm g{XCC, WA, MMAIN, 2048, 1024, LDX, 1024}; pg8::StaticOrder S; S.init(MMAIN, 2048, G, c); EpiGate E{GG, 0}; pg8::gemm_phase(lds3, g, S, E); }
    if (IN(7)) { pg8::Gemm g{BB, WC, MMAIN, 2048, 1024, LDX, 1024}; pg8::StaticOrder S; S.init(MMAIN, 2048, G, c); EpiGate E{GG, 1}; pg8::gemm_phase(lds3, g, S, E); }
    SEAM(7);
    if (IN(8)) { pg8::Gemm g{GG, WO, MMAIN, 2048, DM, LDG, DM}; pg8::StaticOrder S; S.init(MMAIN, 2048, G, c);
        EpiRes E{HB, nullptr, HB, part2, 1.0f}; pg8::gemm_phase(lds3, g, S, E); }
    SEAM(8);
    if (IN(9)) { pg8::Gemm g{HB, WGU2, MMAIN, 11264, DM, DM, DM}; pg8::StaticOrder S; S.init(MMAIN, 11264, G, c); EpiGU E{ACT, part2, (PG8_LAS float*)(lds3 + 131072), -1}; pg8::gemm_phase(lds3, g, S, E); }
    SEAM(9);
    if (IN(10)) { pg8::Gemm g{ACT, WD2, MMAIN, 2048, DFF, DFF, DFF}; pg8::StaticOrder S; S.init(MMAIN, 2048, G, c);
        EpiRes E{HB, P.out, nullptr, nullptr, 0.5f}; pg8::gemm_phase(lds3, g, S, E); }
#undef IN
#undef SEAM
}

extern "C" void kernel_launch(void* const* d_in, const int* in_sizes, int n_in, void* d_out, int out_size, void* d_ws, size_t ws_size, hipStream_t stream) {
    static int grid = 0;
    if (grid == 0) {
        if (n_in != 19 || ws_size < WS_END) { fprintf(stderr, "kernel_launch: unexpected n_in %d / ws_size %zu (need %zu)\n", n_in, ws_size, (size_t)WS_END); grid = -1; return; }
        int dev = 0, cus = 0, per_cu = 0;
        hipGetDevice(&dev); hipDeviceGetAttribute(&cus, hipDeviceAttributeMultiprocessorCount, dev);
        if (hipFuncSetAttribute((const void*)fwd_megakernel, hipFuncAttributeMaxDynamicSharedMemorySize, LDS_BYTES) != hipSuccess) { fprintf(stderr, "kernel_launch: hipFuncSetAttribute failed\n"); grid = -1; return; }
        if (hipOccupancyMaxActiveBlocksPerMultiprocessor(&per_cu, (const void*)fwd_megakernel, 512, LDS_BYTES) != hipSuccess || per_cu < 1) { fprintf(stderr, "kernel_launch: occupancy query says %d\n", per_cu); per_cu = 1; }
        (void)hipGetLastError();
        grid = cus;
    }
    if (grid < 0) return;
    if (hipMemsetAsync((char*)d_ws + WS_BAR, 0, 16384, stream) != hipSuccess) { fprintf(stderr, "kernel_launch: memset failed\n"); return; }
    Params p{};
    p.x = (const float*)d_in[0]; p.meta = (const float*)d_in[1]; p.g1 = (const float*)d_in[2]; p.wg1 = (const float*)d_in[3]; p.wu1 = (const float*)d_in[4]; p.wd1 = (const float*)d_in[5];
    p.gm = (const float*)d_in[6]; p.win = (const float*)d_in[7]; p.qg = (const float*)d_in[8]; p.kg = (const float*)d_in[9]; p.cw = (const float*)d_in[10]; p.cbias = (const float*)d_in[11];
    p.wa = (const float*)d_in[12]; p.wc = (const float*)d_in[13]; p.wo = (const float*)d_in[14]; p.g2 = (const float*)d_in[15]; p.wg2 = (const float*)d_in[16]; p.wu2 = (const float*)d_in[17]; p.wd2 = (const float*)d_in[18];
    p.out = (float*)d_out; p.ws = (unsigned char*)d_ws;
    int lo = 0, hi = 11;
    void* args[] = {&p, &lo, &hi};
    hipError_t e = hipLaunchCooperativeKernel((const void*)fwd_megakernel, dim3(grid), dim3(512), args, LDS_BYTES, stream);
    if (e != hipSuccess) fprintf(stderr, "cooperative launch failed: %s (grid %d)\n", hipGetErrorString(e), grid);
}
```
